# Optimizing an MI355X kernel written in HIP

```python
import jax, jax.numpy as jnp
from jax import lax
import numpy as np

D_MODEL = 2048
BATCH = 4
SEQ = 2048
DEPTH = 2
DEC_BATCH = 8
DEC_SEQ = 16
PAST_LEN = 1024

CHUNK = 64
QBLOCK = 128
HEAD_DIM = 128
H_A = D_MODEL // (2 * HEAD_DIM)
W_A = H_A * HEAD_DIM
H_B = D_MODEL // (2 * HEAD_DIM)
DK_B = 128
DV_B = 128
W_B = H_B * DV_B
H_C = D_MODEL // HEAD_DIM
W_C = H_C * HEAD_DIM
H_X = 4
HD_X = D_MODEL // H_X
N_MEM = 256
D_FF = ((8 * D_MODEL // 3 + 127) // 128) * 128
N_EVEN = (DEPTH + 1) // 2
N_ODD = DEPTH // 2
D_IN_EVEN = 3 * W_A + H_A + 4 * W_B
D_IN_ODD = 3 * W_C
ALPHA = (2.0 * DEPTH) ** 0.25
BETA = (8.0 * DEPTH) ** -0.25
LN_EPS = 1e-5
RMS_EPS = 1e-6
F32 = jnp.float32

kernel_name = 'hybrid_streaming_encoder_step'


def layer_norm(x, g, b):
    mu = jnp.mean(x, axis=-1, keepdims=True)
    var = jnp.mean(jnp.square(x - mu), axis=-1, keepdims=True)
    return (x - mu) * lax.rsqrt(var + LN_EPS) * g.astype(F32) + b.astype(F32)


def post_norm(x, sub, g, b):
    return layer_norm(ALPHA * x.astype(F32) + sub.astype(F32), g, b).astype(x.dtype)


def swiglu_half(x, w_gate, w_up, w_down):
    return 0.5 * ((jax.nn.silu(x @ w_gate) * (x @ w_up)) @ w_down)


def fox_core(q, k, v, cum_q, cum_k, qpos, kpos):
    logits = jnp.einsum('bqhd,bkhd->bhqk', q, k).astype(F32) * (HEAD_DIM ** -0.5)
    bias = jnp.swapaxes(cum_q, 1, 2)[:, :, :, None] - jnp.swapaxes(cum_k, 1, 2)[:, :, None, :]
    mask = qpos[:, None] >= kpos[None, :]
    p = jax.nn.softmax(jnp.where(mask, logits + bias, -jnp.inf), axis=-1)
    return jnp.einsum('bhqk,bkhd->bqhd', p.astype(v.dtype), v)


def fox_prompt(q, k, v, logf):
    B, S, H, D = q.shape
    nb = S // QBLOCK
    cum = jnp.cumsum(logf, axis=1)
    pos = jnp.arange(S)
    qb = q.reshape(B, nb, QBLOCK, H, D).swapaxes(0, 1)
    cb = cum.reshape(B, nb, QBLOCK, H).swapaxes(0, 1)
    pb = pos.reshape(nb, QBLOCK)
    out = lax.map(lambda a: fox_core(a[0], k, v, a[1], cum, a[2], pos), (qb, cb, pb))
    return out.swapaxes(0, 1).reshape(B, S, H * D)


def sb_core(q, k, v, qpos, kpos):
    z = jnp.einsum('bqhd,bkhd->bhqk', q, k).astype(F32) * (HEAD_DIM ** -0.5)
    mask = kpos[None, :] < qpos[:, None]
    log_1m = jnp.where(mask, jax.nn.log_sigmoid(-z), 0.0)
    rem = lax.cumsum(log_1m, axis=3, reverse=True) - log_1m
    w = jnp.where(mask, jnp.exp(jax.nn.log_sigmoid(z) + rem), 0.0)
    return jnp.einsum('bhqk,bkhd->bqhd', w.astype(v.dtype), v)


def sb_prompt(q, k, v):
    B, S, H, D = q.shape
    nb = S // QBLOCK
    pos = jnp.arange(S)
    qb = q.reshape(B, nb, QBLOCK, H, D).swapaxes(0, 1)
    pb = pos.reshape(nb, QBLOCK)
    out = lax.map(lambda a: sb_core(a[0], k, v, a[1], pos), (qb, pb))
    return out.swapaxes(0, 1).reshape(B, S, H * D)


def hgrn_chunk(s0, q, logf, k, i):
    L = q.shape[1]
    b = jnp.cumsum(logf, axis=1)
    causal = (jnp.arange(L)[:, None] >= jnp.arange(L)[None, :])[None, :, :, None, None]
    decay = jnp.exp(jnp.where(causal, b[:, :, None] - b[:, None, :], -jnp.inf))
    scores = jnp.einsum('bthc,btshc,bshc->bhts', q, decay, k)
    o = jnp.einsum('bhts,bshv->bthv', scores, i) + jnp.einsum('bthc,bhcv->bthv', q * jnp.exp(b), s0)
    b_last = b[:, -1]
    s_new = jnp.exp(b_last)[..., None] * s0 + jnp.einsum('bshc,bshv->bhcv', k * jnp.exp(b_last[:, None] - b), i)
    return o, s_new


def hgrn_prompt(q, logf, k, i):
    B, S, H, DK = q.shape
    DV = i.shape[-1]
    n = S // CHUNK
    to_blocks = lambda t: t.reshape(B, n, CHUNK, H, t.shape[-1]).swapaxes(0, 1)

    def step(state, xs):
        o, state = hgrn_chunk(state, *xs)
        return state, o

    s0 = jnp.zeros((B, H, DK, DV), F32)
    s_fin, o = lax.scan(step, s0, (to_blocks(q), to_blocks(logf), to_blocks(k), to_blocks(i)))
    return o.swapaxes(0, 1).reshape(B, S, H, DV), s_fin


def hgrn_lower_bound(lb_logits, j):
    return jnp.cumsum(jax.nn.softmax(lb_logits.astype(F32), axis=0), axis=0)[j]


def even_project(x, w_in, b_f, lb):
    B, T, _ = x.shape
    h = x @ w_in
    offs = np.cumsum([W_A, W_A, W_A, H_A, W_B, W_B, W_B, W_B])[:-1].tolist()
    qa, ka, va, fa, qb, fb, ib, gb = jnp.split(h, offs, axis=-1)
    qa = qa.reshape(B, T, H_A, HEAD_DIM)
    ka = ka.reshape(B, T, H_A, HEAD_DIM)
    va = va.reshape(B, T, H_A, HEAD_DIM)
    logf_a = jax.nn.log_sigmoid(fa.astype(F32) + b_f.astype(F32))
    f_b = lb + (1.0 - lb) * jax.nn.sigmoid(fb.astype(F32))
    logf_b = jnp.log(f_b).reshape(B, T, H_B, DK_B)
    k_b = (1.0 - f_b).reshape(B, T, H_B, DK_B)
    q_b = jax.nn.silu(qb.astype(F32)).reshape(B, T, H_B, DK_B)
    i_b = ib.astype(F32).reshape(B, T, H_B, DV_B)
    return (qa, ka, va, logf_a), (q_b, logf_b, k_b, i_b, gb)


def even_out(o_a, o_b, g_b, norm_g, w_out):
    B, T = o_a.shape[:2]
    ob = o_b * lax.rsqrt(jnp.mean(jnp.square(o_b), axis=-1, keepdims=True) + RMS_EPS)
    ob = ob.reshape(B, T, W_B) * norm_g.astype(F32) * jax.nn.silu(g_b.astype(F32))
    merged = jnp.concatenate([o_a, ob.astype(o_a.dtype)], axis=-1)
    return merged @ w_out


def even_mixer_prompt(x, w_in, b_f, lb, norm_g, w_out):
    (qa, ka, va, lfa), (qb, lfb, kb, ib, gb) = even_project(x, w_in, b_f, lb)
    oa = fox_prompt(qa, ka, va, lfa)
    ob, s_fin = hgrn_prompt(qb, lfb, kb, ib)
    y = even_out(oa, ob, gb, norm_g, w_out)
    return y, ka, va, lfa.astype(x.dtype), s_fin.astype(x.dtype)


def even_mixer_sample(x, c_k, c_v, c_logf, s0, w_in, b_f, lb, norm_g, w_out):
    (qa, ka, va, lfa), (qb, lfb, kb, ib, gb) = even_project(x, w_in, b_f, lb)
    B, T = x.shape[:2]
    P = c_k.shape[1]
    k_all = jnp.concatenate([c_k.astype(ka.dtype), ka], axis=1)
    v_all = jnp.concatenate([c_v.astype(va.dtype), va], axis=1)
    cum = jnp.cumsum(jnp.concatenate([c_logf.astype(F32), lfa], axis=1), axis=1)
    pos = jnp.arange(P + T)
    oa = fox_core(qa, k_all, v_all, cum[:, P:], cum, pos[P:], pos).reshape(B, T, W_A)
    ob, s_new = hgrn_chunk(s0.astype(F32), qb, lfb, kb, ib)
    y = even_out(oa, ob, gb, norm_g, w_out)
    return y, ka, va, lfa.astype(x.dtype), s_new.astype(x.dtype)


def odd_project(x, w_in):
    B, T, _ = x.shape
    q, k, v = jnp.split(x @ w_in, 3, axis=-1)
    r = lambda t: t.reshape(B, T, H_C, HEAD_DIM)
    return r(q), r(k), r(v)


def odd_mixer_prompt(x, w_in, w_out):
    q, k, v = odd_project(x, w_in)
    return sb_prompt(q, k, v) @ w_out, k, v


def odd_mixer_sample(x, c_k, c_v, w_in, w_out):
    q, k, v = odd_project(x, w_in)
    B, T = x.shape[:2]
    P = c_k.shape[1]
    k_all = jnp.concatenate([c_k.astype(k.dtype), k], axis=1)
    v_all = jnp.concatenate([c_v.astype(v.dtype), v], axis=1)
    pos = jnp.arange(P + T)
    o = sb_core(q, k_all, v_all, pos[P:], pos).reshape(B, T, W_C)
    return o @ w_out, k, v


def mem_kv(mem, w_kv):
    B, N, _ = mem.shape
    mk, mv = jnp.split(mem @ w_kv, 2, axis=-1)
    return mk.reshape(B, N, H_X, HD_X), mv.reshape(B, N, H_X, HD_X)


def cross_attend(x, mk, mv, w_q, w_o):
    B, T, _ = x.shape
    q = (x @ w_q).reshape(B, T, H_X, HD_X)
    logits = jnp.einsum('bthd,bmhd->bhtm', q, mk.astype(q.dtype)).astype(F32) * (HD_X ** -0.5)
    p = jax.nn.softmax(logits, axis=-1)
    o = jnp.einsum('bhtm,bmhd->bthd', p.astype(x.dtype), mv.astype(x.dtype)).reshape(B, T, D_MODEL)
    return o @ w_o


def setup_inputs(seed: int = 0) -> dict:
    key = jax.random.key(seed)
    ks = list(jax.random.split(key, 32))
    cnt = [0]

    def nrm(shape, scale):
        k = ks[cnt[0]]
        cnt[0] += 1
        return jax.random.normal(k, shape, F32) * scale

    d_in = float(D_MODEL) ** -0.5
    return {
        'x_prompt': nrm((BATCH, SEQ, D_MODEL), 1.0),
        'x_sample': nrm((DEC_BATCH, DEC_SEQ, D_MODEL), 1.0),
        'mem_prompt': nrm((BATCH, N_MEM, D_MODEL), 1.0),
        'cache_fox_k': nrm((N_EVEN, DEC_BATCH, PAST_LEN, H_A, HEAD_DIM), 1.0),
        'cache_fox_v': nrm((N_EVEN, DEC_BATCH, PAST_LEN, H_A, HEAD_DIM), 1.0),
        'cache_fox_logf': jax.nn.log_sigmoid(2.0 + nrm((N_EVEN, DEC_BATCH, PAST_LEN, H_A), 1.0)),
        'state_hgrn': nrm((N_EVEN, DEC_BATCH, H_B, DK_B, DV_B), 0.5),
        'cache_sb_k': nrm((N_ODD, DEC_BATCH, PAST_LEN, H_C, HEAD_DIM), 1.0),
        'cache_sb_v': nrm((N_ODD, DEC_BATCH, PAST_LEN, H_C, HEAD_DIM), 1.0),
        'cache_mem_k': nrm((DEPTH, DEC_BATCH, N_MEM, H_X, HD_X), 1.0),
        'cache_mem_v': nrm((DEPTH, DEC_BATCH, N_MEM, H_X, HD_X), 1.0),
        'ln_g': 1.0 + nrm((DEPTH, 4, D_MODEL), 0.01),
        'ln_b': nrm((DEPTH, 4, D_MODEL), 0.01),
        'ffn1_w_gate': nrm((DEPTH, D_MODEL, D_FF), d_in),
        'ffn1_w_up': nrm((DEPTH, D_MODEL, D_FF), d_in),
        'ffn1_w_down': nrm((DEPTH, D_FF, D_MODEL), BETA * float(D_FF) ** -0.5),
        'ffn2_w_gate': nrm((DEPTH, D_MODEL, D_FF), d_in),
        'ffn2_w_up': nrm((DEPTH, D_MODEL, D_FF), d_in),
        'ffn2_w_down': nrm((DEPTH, D_FF, D_MODEL), BETA * float(D_FF) ** -0.5),
        'x_w_q': nrm((DEPTH, D_MODEL, D_MODEL), d_in),
        'x_w_kv': nrm((DEPTH, D_MODEL, 2 * D_MODEL), d_in),
        'x_w_o': nrm((DEPTH, D_MODEL, D_MODEL), BETA * d_in),
        'ev_w_in': nrm((N_EVEN, D_MODEL, D_IN_EVEN), d_in),
        'fox_b_f': 2.0 + nrm((N_EVEN, H_A), 0.5),
        'hgrn_lb_logits': nrm((N_EVEN + 1, W_B), 0.1),
        'hgrn_norm_g': 1.0 + nrm((N_EVEN, W_B), 0.01),
        'ev_w_out': nrm((N_EVEN, W_A + W_B, D_MODEL), BETA * float(W_A + W_B) ** -0.5),
        'od_w_in': nrm((N_ODD, D_MODEL, D_IN_ODD), d_in),
        'od_w_out': nrm((N_ODD, W_C, D_MODEL), BETA * float(W_C) ** -0.5),
    }


def reference(x_prompt, x_sample, mem_prompt, cache_fox_k, cache_fox_v, cache_fox_logf, state_hgrn,
              cache_sb_k, cache_sb_v, cache_mem_k, cache_mem_v, ln_g, ln_b,
              ffn1_w_gate, ffn1_w_up, ffn1_w_down, ffn2_w_gate, ffn2_w_up, ffn2_w_down,
              x_w_q, x_w_kv, x_w_o, ev_w_in, fox_b_f, hgrn_lb_logits, hgrn_norm_g, ev_w_out,
              od_w_in, od_w_out):
    xp, xs = x_prompt, x_sample
    fk_p, fv_p, flf_p, hs_p, sk_p, sv_p, mk_p, mv_p = [], [], [], [], [], [], [], []
    fk_s, fv_s, flf_s, hs_s, sk_s, sv_s = [], [], [], [], [], []
    for l in range(DEPTH):
        xp = post_norm(xp, swiglu_half(xp, ffn1_w_gate[l], ffn1_w_up[l], ffn1_w_down[l]), ln_g[l, 0], ln_b[l, 0])
        xs = post_norm(xs, swiglu_half(xs, ffn1_w_gate[l], ffn1_w_up[l], ffn1_w_down[l]), ln_g[l, 0], ln_b[l, 0])
        j = l // 2
        if l % 2 == 0:
            lb = hgrn_lower_bound(hgrn_lb_logits, j)
            mp, kp, vp, lfp, sp = even_mixer_prompt(xp, ev_w_in[j], fox_b_f[j], lb, hgrn_norm_g[j], ev_w_out[j])
            ms, kss, vss, lfs, ss = even_mixer_sample(xs, cache_fox_k[j], cache_fox_v[j], cache_fox_logf[j],
                                                      state_hgrn[j], ev_w_in[j], fox_b_f[j], lb,
                                                      hgrn_norm_g[j], ev_w_out[j])
            fk_p.append(kp); fv_p.append(vp); flf_p.append(lfp); hs_p.append(sp)
            fk_s.append(kss); fv_s.append(vss); flf_s.append(lfs); hs_s.append(ss)
        else:
            mp, kp, vp = odd_mixer_prompt(xp, od_w_in[j], od_w_out[j])
            ms, kss, vss = odd_mixer_sample(xs, cache_sb_k[j], cache_sb_v[j], od_w_in[j], od_w_out[j])
            sk_p.append(kp); sv_p.append(vp)
            sk_s.append(kss); sv_s.append(vss)
        xp = post_norm(xp, mp, ln_g[l, 1], ln_b[l, 1])
        xs = post_norm(xs, ms, ln_g[l, 1], ln_b[l, 1])
        mkp, mvp = mem_kv(mem_prompt, x_w_kv[l])
        mk_p.append(mkp); mv_p.append(mvp)
        xp = post_norm(xp, cross_attend(xp, mkp, mvp, x_w_q[l], x_w_o[l]), ln_g[l, 2], ln_b[l, 2])
        xs = post_norm(xs, cross_attend(xs, cache_mem_k[l], cache_mem_v[l], x_w_q[l], x_w_o[l]), ln_g[l, 2], ln_b[l, 2])
        xp = post_norm(xp, swiglu_half(xp, ffn2_w_gate[l], ffn2_w_up[l], ffn2_w_down[l]), ln_g[l, 3], ln_b[l, 3])
        xs = post_norm(xs, swiglu_half(xs, ffn2_w_gate[l], ffn2_w_up[l], ffn2_w_down[l]), ln_g[l, 3], ln_b[l, 3])
    fox_k_prompt = jnp.stack(fk_p)
    fox_v_prompt = jnp.stack(fv_p)
    fox_logf_prompt = jnp.stack(flf_p)
    hgrn_state_prompt = jnp.stack(hs_p)
    sb_k_prompt = jnp.stack(sk_p)
    sb_v_prompt = jnp.stack(sv_p)
    mem_k_prompt = jnp.stack(mk_p)
    mem_v_prompt = jnp.stack(mv_p)
    fox_k_sample = jnp.stack(fk_s)
    fox_v_sample = jnp.stack(fv_s)
    fox_logf_sample = jnp.stack(flf_s)
    hgrn_state_sample = jnp.stack(hs_s)
    sb_k_sample = jnp.stack(sk_s)
    sb_v_sample = jnp.stack(sv_s)
    return (xp, xs, fox_k_prompt, fox_v_prompt, fox_logf_prompt, hgrn_state_prompt, sb_k_prompt, sb_v_prompt,
            mem_k_prompt, mem_v_prompt, fox_k_sample, fox_v_sample, fox_logf_sample, hgrn_state_sample,
            sb_k_sample, sb_v_sample)
```

```cpp
#include <hip/hip_runtime.h>
#include <cstdio>
#include <cstdint>

#define LAS __attribute__((address_space(3)))
#define GAS __attribute__((address_space(1)))
typedef unsigned short bf16;
typedef short bf16x8 __attribute__((ext_vector_type(8)));
typedef short s16x4 __attribute__((ext_vector_type(4)));
typedef float f32x4 __attribute__((ext_vector_type(4)));
typedef float f32x2 __attribute__((ext_vector_type(2)));
typedef float f32x16 __attribute__((ext_vector_type(16)));
typedef unsigned u32x4 __attribute__((ext_vector_type(4)));
typedef unsigned u32x2 __attribute__((ext_vector_type(2)));
#define DI __device__ __forceinline__
__device__ __forceinline__ int lane_id_() { int l; asm volatile("v_mbcnt_lo_u32_b32 %0, -1, 0\n\tv_mbcnt_hi_u32_b32 %0, -1, %0" : "=v"(l)); return l; }

constexpr int DM = 2048, BATCH = 4, SEQ = 2048, DEC_B = 8, DEC_T = 16, PAST = 1024;
constexpr int MP = BATCH * SEQ;
constexpr int MS = DEC_B * DEC_T;
constexpr int MT = MP + MS;
constexpr int HD = 128, H_A = 8, W_A = 1024, H_B = 8, W_B = 1024, H_C = 16, W_C = 2048, H_X = 4, HD_X = 512, N_MEM = 256;
constexpr int D_FF = 5504, NGU = 2 * D_FF;
constexpr int D_IN_EVEN = 7176, NE = 7424;
constexpr int D_IN_ODD = 6144;
constexpr float ALPHA = 1.41421356237309515f;
constexpr float LN_EPS = 1e-5f, RMS_EPS = 1e-6f;
constexpr float LOG2E = 1.4426950408889634f, LN2 = 0.6931471805599453f;

constexpr size_t O_Y = 0, O_YS = O_Y + (size_t)MP * DM, O_FK = O_YS + (size_t)MS * DM, O_FV = O_FK + (size_t)MP * W_A, O_FLF = O_FV + (size_t)MP * W_A,
    O_HS = O_FLF + (size_t)MP * H_A, O_SK = O_HS + (size_t)BATCH * H_B * 128 * 128, O_SV = O_SK + (size_t)MP * W_C, O_MK = O_SV + (size_t)MP * W_C,
    O_MV = O_MK + (size_t)2 * BATCH * N_MEM * DM, O_FKS = O_MV + (size_t)2 * BATCH * N_MEM * DM, O_FVS = O_FKS + (size_t)MS * W_A, O_FLFS = O_FVS + (size_t)MS * W_A,
    O_HSS = O_FLFS + (size_t)MS * H_A, O_SKS = O_HSS + (size_t)DEC_B * H_B * 128 * 128, O_SVS = O_SKS + (size_t)MS * W_C, O_END = O_SVS + (size_t)MS * W_C;

constexpr size_t MiB = 1u << 20;
constexpr size_t al(size_t x) { return (x + 255) & ~(size_t)255; }
constexpr size_t WS_CTL = 0, CTL_ZERO_BYTES = 1 * MiB;
constexpr size_t SZ_WGU = (size_t)NGU * DM * 2, SZ_WD = (size_t)DM * D_FF * 2, SZ_W22 = (size_t)DM * DM * 2, SZ_WKV = (size_t)2 * DM * DM * 2;
constexpr size_t WS_WGU = 2 * MiB;
constexpr size_t WS_WD = WS_WGU + 4 * SZ_WGU;
constexpr size_t WS_WQ = WS_WD + 4 * SZ_WD;
constexpr size_t WS_WKV = WS_WQ + 2 * SZ_W22;
constexpr size_t WS_WO = WS_WKV + 2 * SZ_WKV;
constexpr size_t WS_WINE = WS_WO + 2 * SZ_W22;
constexpr size_t WS_WOUTE = WS_WINE + (size_t)NE * DM * 2;
constexpr size_t WS_WINO = WS_WOUTE + SZ_W22;
constexpr size_t WS_WOUTO = WS_WINO + (size_t)D_IN_ODD * DM * 2;
constexpr size_t WS_X32 = al(WS_WOUTO + SZ_W22);
constexpr size_t WS_XB = al(WS_X32 + (size_t)MT * DM * 4);
constexpr size_t WS_H = al(WS_XB + (size_t)MT * DM * 2);
constexpr size_t WS_MRG = al(WS_H + (size_t)MT * D_FF * 2);
constexpr size_t WS_Q = al(WS_MRG + (size_t)MT * DM * 2);
constexpr size_t WS_KB = al(WS_Q + (size_t)MT * DM * 2);
constexpr size_t WS_VB = al(WS_KB + (size_t)MP * DM * 2);
constexpr size_t WS_QBB = al(WS_VB + (size_t)MP * DM * 2);
constexpr size_t WS_IBB = al(WS_QBB + (size_t)MT * W_B * 2);
constexpr size_t WS_GBB = al(WS_IBB + (size_t)MT * W_B * 2);
constexpr size_t WS_LFB = al(WS_GBB + (size_t)MT * W_B * 2);
constexpr size_t WS_MEMB = al(WS_LFB + (size_t)MT * W_B * 4);
constexpr size_t WS_MEMK = al(WS_MEMB + (size_t)1024 * DM * 2);
constexpr size_t WS_MEMVT = al(WS_MEMK + (size_t)2 * 1024 * DM * 2);
constexpr size_t WS_P = al(WS_MEMVT + (size_t)2 * 1024 * DM * 2);
constexpr size_t WS_DS = al(WS_P + (size_t)MP * 1024 * 2);
constexpr size_t WS_DC = al(WS_DS + (size_t)1024 * 128 * 128 * 4);
constexpr size_t WS_SC = al(WS_DC + (size_t)1024 * 128 * 4);
constexpr size_t WS_END = al(WS_SC + (size_t)1024 * 128 * 128 * 2);

constexpr int CW_TMO = 0;
constexpr int CW_BAR = 4096;

constexpr int RING_BYTES = 131072;
constexpr int MISC_OFF = RING_BYTES + 320;
constexpr int LDS_BYTES = 147456;
constexpr int NWAVES = 8, NTHREADS = 512;
constexpr int PH_PER_LAYER = 17;
constexpr int N_PHASES_DBG = 2 + 2 * PH_PER_LAYER;

#define LDS_WAIT() asm volatile("s_waitcnt lgkmcnt(0)" ::: "memory")
#define VM_WAIT() asm volatile("s_waitcnt vmcnt(0)" ::: "memory")
DI unsigned f2bf(float f) { unsigned u = __builtin_bit_cast(unsigned, f); return (u + 0x7fffu + ((u >> 16) & 1u)) >> 16; }
DI unsigned pk2(float lo, float hi) { unsigned r; asm volatile("v_cvt_pk_bf16_f32 %0, %1, %2" : "=v"(r) : "v"(lo), "v"(hi)); return r; }
DI float bf2f(unsigned short b) { return __builtin_bit_cast(float, (unsigned)b << 16); }
DI float wave_sum(float v) {
#pragma unroll
    for (int o = 1; o < 64; o <<= 1) v += __shfl_xor(v, o);
    return v;
}
DI float fexp2(float x) { return __builtin_amdgcn_exp2f(x); }
DI float flog2(float x) { return __builtin_amdgcn_logf(x); }
DI float sigmoidf_(float x) { return 1.0f / (1.0f + __expf(-x)); }
DI float siluf_(float x) { return x / (1.0f + __expf(-x)); }
DI float logsigmoidf_(float x) { return fminf(x, 0.f) - log1pf(__expf(-fabsf(x))); }

#define XB_TMO      128
#define XB_XCNT(j)  (256  + 64 * (j))
#define XB_XSUB(j)  (1280 + 64 * (j))
#define XB_XGEN(j)  (2304 + 64 * (j))
#define XB_TOP      3328
#define XB_TOPGEN   3392
#define XCD_BAR_WORDS 3456
#define XB_SPIN_CAP (1u << 18)
__device__ __forceinline__ unsigned xb_ld(unsigned* p)              { return __hip_atomic_load(p, __ATOMIC_RELAXED, __HIP_MEMORY_SCOPE_AGENT); }
__device__ __forceinline__ unsigned xb_add(unsigned* p, unsigned v) { return __hip_atomic_fetch_add(p, v, __ATOMIC_RELAXED, __HIP_MEMORY_SCOPE_AGENT); }
__device__ __forceinline__ unsigned xb_xcc_id() { return (unsigned)__builtin_amdgcn_s_getreg((3 << 11) | 20) & 0xFu; }
#define XB_SPIN(cond, bar) do { unsigned _sp = 0; while (cond) { __builtin_amdgcn_s_sleep(1); \
    if ((++_sp & 255u) == 0u) { if (xb_ld(&(bar)[XB_TMO])) break; if (_sp > XB_SPIN_CAP) { atomicAdd(&(bar)[XB_TMO], 1u); break; } } } } while (0)
struct XcdBarrier { unsigned* bar; unsigned x; volatile LAS unsigned* st; int wv; };
__device__ __forceinline__ XcdBarrier xcd_barrier_post(unsigned* bar, volatile LAS unsigned* st) {
    XcdBarrier b; b.bar = bar; b.x = xb_xcc_id(); b.st = st;
    if (threadIdx.x == 0) (void)xb_add(&bar[XB_XCNT(b.x)], 1u);
    return b;
}
__device__ __forceinline__ void xcd_barrier_complete(unsigned* bar, unsigned x, unsigned& nloc, unsigned& nx) {
    const unsigned G = gridDim.x * gridDim.y * gridDim.z;
    unsigned sum, cnt, mine, sp = 0u;
    for (;;) {
        sum = 0u; cnt = 0u; mine = 0u;
#pragma unroll
        for (unsigned j = 0; j < 16; ++j) { const unsigned c = xb_ld(&bar[XB_XCNT(j)]); sum += c; cnt += (c > 0u) ? 1u : 0u; mine = (j == x) ? c : mine; }
        if (sum == G) break;
        __builtin_amdgcn_s_sleep(1);
        if ((++sp & 255u) == 0u) { if (xb_ld(&bar[XB_TMO])) break; if (sp > XB_SPIN_CAP) { atomicAdd(&bar[XB_TMO], 1u); break; } }
    }
    nloc = mine > 0u ? mine : 1u; nx = cnt > 0u ? cnt : 1u;
}
__device__ __forceinline__ void xcd_barrier(const XcdBarrier& b) {
    asm volatile("s_waitcnt vmcnt(0)" ::: "memory");
    __syncthreads();
    if (b.wv == 0 && lane_id_() == 0) {
        size_t zb = 0; asm volatile("" : "+s"(zb)); unsigned* bar = b.bar + zb;
        __builtin_amdgcn_s_waitcnt(0);
        unsigned nloc = b.st[0], nx = b.st[1];
        unsigned bx = b.x; asm volatile("" : "+s"(bx));
        if (nloc == 0u) { xcd_barrier_complete(bar, bx, nloc, nx); b.st[0] = nloc; b.st[1] = nx; }
        const unsigned old = xb_add(&bar[XB_XSUB(bx)], 1u);
        const unsigned gen = old / nloc;
        if (old + 1u == (gen + 1u) * nloc) {
            __builtin_amdgcn_fence(__ATOMIC_RELEASE, "agent");
            asm volatile("s_waitcnt vmcnt(0)" ::: "memory");
            const unsigned og = xb_add(&bar[XB_TOP], 1u);
            const unsigned tg = og / nx;
            if (og + 1u == (tg + 1u) * nx) xb_add(&bar[XB_TOPGEN], 1u);
            else XB_SPIN(xb_ld(&bar[XB_TOPGEN]) == tg, bar);
            __builtin_amdgcn_fence(__ATOMIC_ACQUIRE, "agent");
            xb_add(&bar[XB_XGEN(bx)], 1u);
            asm volatile("s_waitcnt vmcnt(0)" ::: "memory");
        } else {
            XB_SPIN(xb_ld(&bar[XB_XGEN(bx)]) == gen, bar);
            __builtin_amdgcn_fence(__ATOMIC_ACQUIRE, "agent");
            asm volatile("s_waitcnt vmcnt(0)" ::: "memory");
        }
    }
    __syncthreads();
}

namespace pg8 {
constexpr int BM = 256, BK = 64, HALF = 128, HTB = HALF * BK * 2, STAGE_BYTES = 8 * HTB, NXCD = 8, WGM = 8;
DI int lds_byte(int r, int c) { const int st = (r >> 4) * 2 + (c >> 5), rr = r & 15, cc = c & 31, ob = rr * 64 + cc * 2; return st * 1024 + (ob ^ (((ob >> 9) & 1) << 5)); }
DI void stage_rc(int b, int& R, int& C) { const int st = b / 1024, sb = b % 1024, swz = sb ^ (((sb >> 9) & 1) << 5); R = (st >> 1) * 16 + swz / 64; C = (st & 1) * 32 + (swz % 64) / 2; }
struct Unit { int pm, pn, z; };
struct GridOrder {
    const bf16* A; const bf16* Bt; int lda, ldb; int nM, nN, nwg, G, c;
    DI void init(const bf16* A_, int lda_, const bf16* Bt_, int ldb_, int nM_, int nN_, int G_, int c_) { A = A_; Bt = Bt_; lda = lda_; ldb = ldb_; nM = nM_; nN = nN_; nwg = nM * nN; G = G_; c = c_; }
    DI bool next(int i, Unit& u) const {
        const long L = (long)i * G + c; if (L >= nwg) return false;
        int wgid = (int)L; { const int q = nwg / NXCD, r = nwg % NXCD, xcd = wgid % NXCD, off = wgid / NXCD; wgid = (xcd < r ? xcd * (q + 1) : r * (q + 1) + (xcd - r) * q) + off; }
        const int nig = WGM * nN, gid = wgid / nig, fm = gid * WGM, gsz = (nM - fm) < WGM ? (nM - fm) : WGM;
        u.pm = fm + ((wgid % nig) % gsz); u.pn = (wgid % nig) / gsz; u.z = 0; return true;
    }
    DI const char* pa(const Unit& u) const { return (const char*)(A + (size_t)u.pm * 256 * lda); }
    DI const char* pb(const Unit& u) const { return (const char*)(Bt + (size_t)u.pn * 256 * ldb); }
};

template <class Epi, class Sched>
__device__ __forceinline__ void gemm_phase(LAS unsigned char* lds, const Sched& S, const int K, const Epi& E, const int wv_) {
    const int tid = wv_ * 64 + lane_id_();
    const int wid = __builtin_amdgcn_readfirstlane(tid >> 6), lane = tid & 63, wr = wid >> 2, wc = wid & 3, fr = lane & 15, fq = lane >> 4;
    const int nt = K / BK;
    const int lda = S.lda, ldb = S.ldb;
    unsigned voffA[2], voffB[2];
#pragma unroll
    for (int i = 0; i < 2; ++i) { int R, C; stage_rc(tid * 16 + i * 8192, R, C);
        voffA[i] = (unsigned)(R * lda + C) * 2u; voffB[i] = (unsigned)(R * ldb + C) * 2u; }
    const size_t kstep = (size_t)(BK * 2);
    const size_t hstepA = (size_t)HALF * lda * 2, hstepB = (size_t)HALF * ldb * 2;
    const unsigned ldsw = (unsigned)wid * 1024u;
    const int aoff = lds_byte(wr * 64 + fr, fq * 8), boff = lds_byte(wc * 32 + fr, fq * 8);
#define PG8_SA(b, h) (((b) * 2 + (h)) * HTB)
#define PG8_SB(b, h) ((4 + (b) * 2 + (h)) * HTB)
#define PG8_STAGE(bufoff, gbase, voff) do { _Pragma("unroll") for (int _i = 0; _i < 2; ++_i) \
        __builtin_amdgcn_global_load_lds((const unsigned*)((const char*)(gbase) + (voff)[_i]), (LAS unsigned*)(lds + (bufoff) + ldsw + _i * 8192), 16, 0, 0); } while (0)
#define PG8_LDA(dst, b, h) do { _Pragma("unroll") for (int m = 0; m < 4; ++m) _Pragma("unroll") for (int k = 0; k < 2; ++k) dst[m][k] = *(const LAS bf16x8*)(lds + PG8_SA(b, h) + aoff + m * 2048 + k * 1024); } while (0)
#define PG8_LDB(dst, b, h) do { _Pragma("unroll") for (int n = 0; n < 2; ++n) _Pragma("unroll") for (int k = 0; k < 2; ++k) dst[n][k] = *(const LAS bf16x8*)(lds + PG8_SB(b, h) + boff + n * 2048 + k * 1024); } while (0)
#define PG8_MMA(ai, bj, At, Bt) do { __builtin_amdgcn_s_setprio(1); _Pragma("unroll") for (int m = 0; m < 4; ++m) _Pragma("unroll") for (int n = 0; n < 2; ++n) _Pragma("unroll") for (int k = 0; k < 2; ++k) \
        acc[ai][bj][m][n] = __builtin_amdgcn_mfma_f32_16x16x32_bf16(Bt[n][k], At[m][k], acc[ai][bj][m][n], 0, 0, 0); __builtin_amdgcn_s_setprio(0); } while (0)
#define PG8_WAIT_V(n) asm volatile("s_waitcnt vmcnt(" #n ")" ::: "memory")
#define PG8_WAIT_L(n) asm volatile("s_waitcnt lgkmcnt(" #n ")" ::: "memory")
#define PG8_BAR __builtin_amdgcn_s_barrier()
#define PG8_SCHED __builtin_amdgcn_sched_barrier(0)
    Unit cur, nxt; int ui = 0;
    if (!S.next(0, cur)) return;
    f32x4 acc[2][2][4][2];
#pragma unroll
    for (int a = 0; a < 2; ++a)
#pragma unroll
        for (int b = 0; b < 2; ++b)
#pragma unroll
            for (int m = 0; m < 4; ++m)
#pragma unroll
                for (int n = 0; n < 2; ++n) acc[a][b][m][n] = (f32x4){0.f, 0.f, 0.f, 0.f};
    bf16x8 At[4][2], B0[2][2], B1[2][2];
    const char* cA = S.pa(cur); const char* cB = S.pb(cur);
    {
        PG8_STAGE(PG8_SB(0, 0), cB, voffB); PG8_STAGE(PG8_SB(0, 1), cB + hstepB, voffB); PG8_STAGE(PG8_SA(0, 0), cA, voffA); PG8_STAGE(PG8_SA(0, 1), cA + hstepA, voffA);
        if (wr == 1) PG8_BAR;
        PG8_WAIT_V(2); PG8_BAR;
        PG8_STAGE(PG8_SB(1, 0), cB + kstep, voffB); PG8_STAGE(PG8_SA(1, 0), cA + kstep, voffA); PG8_STAGE(PG8_SB(1, 1), cB + hstepB + kstep, voffB);
        PG8_WAIT_V(6); PG8_BAR;
    }
    for (;;) {
        const bool has_next = S.next(ui + 1, nxt);
        const char* nA = has_next ? S.pa(nxt) : cA; const char* nB = has_next ? S.pb(nxt) : cB;
        for (int t = 0; t < nt; t += 2) {
            const bool last = (t == nt - 2);
            const char* a1 = cA + (size_t)(t + 1) * kstep;
            const char* a2 = last ? nA : cA + (size_t)(t + 2) * kstep; const char* b2 = last ? nB : cB + (size_t)(t + 2) * kstep;
            const char* a3 = a2 + kstep; const char* b3 = b2 + kstep;
            PG8_LDB(B0, 0, 0); PG8_LDB(B1, 0, 1); PG8_SCHED; PG8_LDA(At, 0, 0); PG8_STAGE(PG8_SA(1, 1), a1 + hstepA, voffA);
            PG8_WAIT_V(8); PG8_WAIT_L(0); PG8_BAR; PG8_MMA(0, 0, At, B0); PG8_MMA(0, 1, At, B1); PG8_BAR; PG8_SCHED;
            PG8_LDA(At, 0, 1); PG8_STAGE(PG8_SB(0, 0), b2, voffB); PG8_STAGE(PG8_SB(0, 1), b2 + hstepB, voffB); PG8_STAGE(PG8_SA(0, 0), a2, voffA);
            PG8_WAIT_V(8); PG8_WAIT_L(0); PG8_BAR; PG8_MMA(1, 0, At, B0); PG8_MMA(1, 1, At, B1); PG8_BAR; PG8_SCHED;
            PG8_LDB(B0, 1, 0); PG8_LDB(B1, 1, 1); PG8_SCHED; PG8_LDA(At, 1, 0); PG8_STAGE(PG8_SA(0, 1), a2 + hstepA, voffA);
            PG8_WAIT_V(8); PG8_WAIT_L(0); PG8_BAR; PG8_MMA(0, 0, At, B0); PG8_MMA(0, 1, At, B1); PG8_BAR; PG8_SCHED;
            PG8_LDA(At, 1, 1); PG8_STAGE(PG8_SB(1, 0), b3, voffB); PG8_STAGE(PG8_SB(1, 1), b3 + hstepB, voffB); PG8_STAGE(PG8_SA(1, 0), a3, voffA);
            PG8_WAIT_V(8); PG8_WAIT_L(0); PG8_BAR; PG8_MMA(1, 0, At, B0); PG8_MMA(1, 1, At, B1); PG8_BAR; PG8_SCHED;
        }
        if (wr == 0) PG8_BAR;
        if constexpr (!Epi::AFTER_DRAIN) { E(acc, cur, wr, wc, fr, fq); }
        if (!has_next) break;
#pragma unroll
        for (int a = 0; a < 2; ++a)
#pragma unroll
            for (int b = 0; b < 2; ++b)
#pragma unroll
                for (int m = 0; m < 4; ++m)
#pragma unroll
                    for (int n = 0; n < 2; ++n) acc[a][b][m][n] = (f32x4){0.f, 0.f, 0.f, 0.f};
        cur = nxt; cA = nA; cB = nB; ++ui;
        if (wr == 1) PG8_BAR;
    }
    PG8_WAIT_V(0);
    PG8_BAR;
    if constexpr (Epi::AFTER_DRAIN) { E.fused(acc, cur, wr, wc, fr, fq, lds, wid, lane); }
#undef PG8_SA
#undef PG8_SB
#undef PG8_STAGE
#undef PG8_LDA
#undef PG8_LDB
#undef PG8_MMA
#undef PG8_WAIT_V
#undef PG8_WAIT_L
#undef PG8_BAR
#undef PG8_SCHED
}

template <class F> struct EpiEach {
    static constexpr bool AFTER_DRAIN = false;
    F f;
    DI void operator()(const f32x4 (&acc)[2][2][4][2], const Unit& u, int wr, int wc, int fr, int fq) const {
#pragma unroll
        for (int ai = 0; ai < 2; ++ai)
#pragma unroll
            for (int m = 0; m < 4; ++m) { const int row = u.pm * BM + ai * HALF + wr * 64 + m * 16 + fr;
#pragma unroll
                for (int bj = 0; bj < 2; ++bj)
#pragma unroll
                    for (int n = 0; n < 2; ++n) f.apply4(u, row, u.pn * BM + bj * HALF + wc * 32 + n * 16 + 4 * fq, acc[ai][bj][m][n]);
                asm volatile("" ::: "memory"); }
    }
};
template <class F> struct EpiPair {
    static constexpr bool AFTER_DRAIN = false;
    F f;
    DI void operator()(const f32x4 (&acc)[2][2][4][2], const Unit& u, int wr, int wc, int fr, int fq) const {
#pragma unroll
        for (int ai = 0; ai < 2; ++ai)
#pragma unroll
            for (int m = 0; m < 4; ++m) { const int row = u.pm * BM + ai * HALF + wr * 64 + m * 16 + fr;
#pragma unroll
                for (int n = 0; n < 2; ++n) f.pair4(row, u.pn * HALF + wc * 32 + n * 16 + 4 * fq, acc[ai][0][m][n], acc[ai][1][m][n]);
                asm volatile("" ::: "memory"); }
    }
};
}

template <bool PAIR, class F>
__device__ __forceinline__ void skinny_phase(LAS unsigned char* lds, const bf16* A, int lda, const bf16* Bt, int ldb, int K, int nunits, const F& f, const int wv_) {
    const int tid = wv_ * 64 + lane_id_();
    const int wid = __builtin_amdgcn_readfirstlane(tid >> 6), lane = tid & 63, l15 = lane & 15, lq = lane >> 4;
    const int G = gridDim.x, c = (int)blockIdx.x;
    const int nks = K / 32, ks0 = (wid * nks) / 8, ks1 = ((wid + 1) * nks) / 8;
    for (int j = G - 1 - c; j < nunits; j += G) {
        int c0, c1;
        if (PAIR) { c0 = (j >> 3) * 256 + (j & 7) * 16; c1 = c0 + 128; } else { c0 = 32 * j; c1 = c0 + 16; }
        f32x4 acc[2][8];
#pragma unroll
        for (int nb = 0; nb < 2; ++nb)
#pragma unroll
            for (int i = 0; i < 8; ++i) acc[nb][i] = (f32x4){0.f, 0.f, 0.f, 0.f};
        const bf16* w0 = Bt + (size_t)(c0 + l15) * ldb + lq * 8;
        const bf16* w1 = Bt + (size_t)(c1 + l15) * ldb + lq * 8;
        const bf16* ap = A + (size_t)l15 * lda + lq * 8;
#pragma unroll 2
        for (int ks = ks0; ks < ks1; ++ks) {
            const bf16x8 wa = *(const bf16x8*)(w0 + ks * 32), wb = *(const bf16x8*)(w1 + ks * 32);
            bf16x8 xa[8];
#pragma unroll
            for (int i = 0; i < 8; ++i) xa[i] = *(const bf16x8*)(ap + (size_t)(16 * i) * lda + ks * 32);
#pragma unroll
            for (int i = 0; i < 8; ++i) { acc[0][i] = __builtin_amdgcn_mfma_f32_16x16x32_bf16(wa, xa[i], acc[0][i], 0, 0, 0); acc[1][i] = __builtin_amdgcn_mfma_f32_16x16x32_bf16(wb, xa[i], acc[1][i], 0, 0, 0); }
        }
        __syncthreads();
#pragma unroll
        for (int nb = 0; nb < 2; ++nb)
#pragma unroll
            for (int i = 0; i < 8; ++i) *(LAS f32x4*)(lds + ((((wid * 2 + nb) * 8 + i) * 64 + lane) * 16)) = acc[nb][i];
        __syncthreads();
        {
            const int i = tid >> 6, lp = tid & 63;
            f32x4 v0 = (f32x4){0.f, 0.f, 0.f, 0.f}, v1 = v0;
#pragma unroll
            for (int w = 0; w < 8; ++w) { v0 += *(const LAS f32x4*)(lds + ((((w * 2 + 0) * 8 + i) * 64 + lp) * 16)); v1 += *(const LAS f32x4*)(lds + ((((w * 2 + 1) * 8 + i) * 64 + lp) * 16)); }
            const int row = 16 * i + (lp & 15), cq = 4 * (lp >> 4);
            if constexpr (PAIR) f.pair4(MP + row, (j >> 3) * 128 + (j & 7) * 16 + cq, v0, v1);
            else { pg8::Unit u{0, 0, 0}; f.apply4(u, MP + row, c0 + cq, v0); f.apply4(u, MP + row, c1 + cq, v1); }
        }
    }
    __syncthreads();
}


#define MFMA32(a, b, c) __builtin_amdgcn_mfma_f32_32x32x16_bf16((a), (b), (c), 0, 0, 0)
constexpr int TS = 272;
DI int pi32(int r) { return (r & ~12) | ((r & 4) << 1) | ((r & 8) >> 1); }
DI int keyloc(int i, int hh) { return 16 * (i >> 3) + 8 * hh + (i & 7); }
DI bf16x8 frag_tr(LAS const unsigned char* img, int st, int k0, int m0, int lane) {
    const int hh = lane >> 5, blk = (lane >> 4) & 1, i16 = lane & 15, q = i16 >> 2, p = i16 & 3;
    LAS const unsigned char* a = img + (k0 + 8 * hh + q) * st + (m0 + 16 * blk) * 2 + 8 * p;
    const s16x4 lo = __builtin_amdgcn_ds_read_tr16_b64_v4i16((LAS s16x4*)a), hi = __builtin_amdgcn_ds_read_tr16_b64_v4i16((LAS s16x4*)(a + 4 * st));
    return __builtin_shufflevector(lo, hi, 0, 1, 2, 3, 4, 5, 6, 7);
}
DI bf16x8 frag_row(LAS const unsigned char* img, int st, int row, int k0, int hh) { return *(const LAS bf16x8*)(img + row * st + (k0 + 8 * hh) * 2); }
DI bf16x8 pack8(const f32x16& x, int s) {
    u32x4 p; p[0] = pk2(x[8 * s + 0], x[8 * s + 1]); p[1] = pk2(x[8 * s + 2], x[8 * s + 3]); p[2] = pk2(x[8 * s + 4], x[8 * s + 5]); p[3] = pk2(x[8 * s + 6], x[8 * s + 7]);
    return __builtin_bit_cast(bf16x8, p);
}
DI f32x16 zero16() { f32x16 z;
#pragma unroll
    for (int i = 0; i < 16; ++i) z[i] = 0.f; return z; }
DI void block_scan(LAS float* a, int n, LAS float* tmp, int tid) {
    const int lane = tid & 63, wid = tid >> 6;
    f32x4 v = (f32x4){0.f, 0.f, 0.f, 0.f};
    if (tid * 4 < n) v = *(LAS f32x4*)(a + tid * 4);
    v[1] += v[0]; v[2] += v[1]; v[3] += v[2];
    float s = v[3];
#pragma unroll
    for (int o = 1; o < 64; o <<= 1) { const float t = __shfl_up(s, o); if (lane >= o) s += t; }
    if (lane == 63) tmp[wid] = s;
    __syncthreads();
    float off = s - v[3];
    for (int w = 0; w < wid; ++w) off += tmp[w];
    if (tid * 4 < n) *(LAS f32x4*)(a + tid * 4) = v + off;
    __syncthreads();
}

template <bool SB>
DI void attn_prompt_unit(LAS unsigned char* lds, const bf16* q, const bf16* k, const bf16* v, bf16* out, int b, int hcol, int ocol, int qb, LAS const float* negc, const int wv_) {
    const int tid = wv_ * 64 + lane_id_();
    const int lane = tid & 63, wid = __builtin_amdgcn_readfirstlane(tid >> 6), r = lane & 31, hh = lane >> 5;
    LAS unsigned char* Kt = lds + 16384;
    LAS unsigned char* Vt = Kt + 2 * 64 * TS;
    const int q0 = 256 * qb + 32 * wid;
    const size_t rowb = (size_t)b * SEQ;
    bf16x8 Qf[8];
#pragma unroll
    for (int ks = 0; ks < 8; ++ks) Qf[ks] = *(const bf16x8*)(q + (rowb + q0 + r) * DM + hcol + 16 * ks + 8 * hh);
    f32x16 O[4];
#pragma unroll
    for (int d = 0; d < 4; ++d) O[d] = zero16();
    float m = -INFINITY, l = 0.f, carry = 0.f;
    const int ktmax = 4 * qb + 3, ntile = ktmax + 1;
    const int lrow = tid >> 3, lch = (tid & 7) * 2;
    u32x4 kr[2], vr[2];
    auto gload = [&](int kt) {
        const size_t base = (rowb + 64 * kt + lrow) * DM + hcol + lch * 8;
        kr[0] = *(const u32x4*)(k + base); kr[1] = *(const u32x4*)(k + base + 8); vr[0] = *(const u32x4*)(v + base); vr[1] = *(const u32x4*)(v + base + 8); };
    auto lstore = [&](int buf) {
        LAS unsigned char* kp = Kt + buf * 64 * TS + lrow * TS + lch * 16; LAS unsigned char* vp = Vt + buf * 64 * TS + lrow * TS + lch * 16;
        *(LAS u32x4*)kp = kr[0]; *(LAS u32x4*)(kp + 16) = kr[1]; *(LAS u32x4*)vp = vr[0]; *(LAS u32x4*)(vp + 16) = vr[1]; };
    auto tile_of = [&](int it) { return SB ? (ktmax - it) : it; };
    __syncthreads();
    gload(tile_of(0)); lstore(0);
    __syncthreads();
    for (int it = 0; it < ntile; ++it) {
        const int kt = tile_of(it), buf = it & 1;
        if (it + 1 < ntile) gload(tile_of(it + 1));
        const int key0 = 64 * kt;
        const bool relevant = SB ? (key0 < q0 + 31) : (key0 <= q0 + 31);
        if (relevant) {
            const bool full = SB ? (key0 + 63 < q0) : (key0 + 63 <= q0);
            LAS const unsigned char* Kb = Kt + buf * 64 * TS; LAS const unsigned char* Vb = Vt + buf * 64 * TS;
            f32x16 S[2];
#pragma unroll
            for (int blk = 0; blk < 2; ++blk) {
                if (!SB) {
#pragma unroll
                    for (int g = 0; g < 2; ++g) { const f32x4 c0 = *(const LAS f32x4*)(negc + key0 + 32 * blk + 16 * g + 8 * hh), c1 = *(const LAS f32x4*)(negc + key0 + 32 * blk + 16 * g + 8 * hh + 4);
                        S[blk][8 * g + 0] = c0[0]; S[blk][8 * g + 1] = c0[1]; S[blk][8 * g + 2] = c0[2]; S[blk][8 * g + 3] = c0[3]; S[blk][8 * g + 4] = c1[0]; S[blk][8 * g + 5] = c1[1]; S[blk][8 * g + 6] = c1[2]; S[blk][8 * g + 7] = c1[3]; }
                } else S[blk] = zero16();
#pragma unroll
                for (int ks = 0; ks < 8; ++ks) S[blk] = MFMA32(frag_row(Kb, TS, 32 * blk + pi32(r), 16 * ks, hh), Qf[ks], S[blk]);
            }
            const int qq = q0 + r;
            if (!SB) {
                if (!full) {
#pragma unroll
                    for (int blk = 0; blk < 2; ++blk)
#pragma unroll
                        for (int i = 0; i < 16; ++i) if (key0 + 32 * blk + keyloc(i, hh) > qq) S[blk][i] = -INFINITY;
                }
                float mx = S[0][0];
#pragma unroll
                for (int blk = 0; blk < 2; ++blk)
#pragma unroll
                    for (int i = 0; i < 16; ++i) mx = fmaxf(mx, S[blk][i]);
                mx = fmaxf(mx, __shfl_xor(mx, 32));
                const float mn = fmaxf(m, mx), corr = fexp2(m - mn);
                float ps = 0.f;
#pragma unroll
                for (int blk = 0; blk < 2; ++blk)
#pragma unroll
                    for (int i = 0; i < 16; ++i) { S[blk][i] = fexp2(S[blk][i] - mn); ps += S[blk][i]; }
                l = l * corr + ps; m = mn;
#pragma unroll
                for (int d = 0; d < 4; ++d) O[d] = O[d] * corr;
            } else {
                f32x16 L[2]; float G[4], Go[4];
#pragma unroll
                for (int blk = 0; blk < 2; ++blk)
#pragma unroll
                    for (int g = 0; g < 2; ++g) { float gs = 0.f;
#pragma unroll
                        for (int j = 0; j < 8; ++j) { const int i = 8 * g + j; const float z = S[blk][i];
                            const bool ok = full || (key0 + 32 * blk + keyloc(i, hh) < qq);
                            const float lsm = ok ? -(fmaxf(z, 0.f) + flog2(1.0f + fexp2(-fabsf(z)))) : 0.f;
                            L[blk][i] = lsm; S[blk][i] = ok ? z : -INFINITY; gs += lsm; }
                        G[2 * blk + g] = gs; }
#pragma unroll
                for (int u = 0; u < 4; ++u) Go[u] = __shfl_xor(G[u], 32);
                float above = carry;
#pragma unroll
                for (int u = 3; u >= 0; --u) {
                    float run = above + (hh == 0 ? Go[u] : 0.f);
                    const int blk = u >> 1, g = u & 1;
#pragma unroll
                    for (int j = 7; j >= 0; --j) { const int i = 8 * g + j; run += L[blk][i]; S[blk][i] = fexp2(S[blk][i] + run); }
                    above += G[u] + Go[u];
                }
                carry = above;
            }
#pragma unroll
            for (int ks = 0; ks < 4; ++ks) { const bf16x8 pf = pack8(S[ks >> 1], ks & 1);
#pragma unroll
                for (int d = 0; d < 4; ++d) O[d] = MFMA32(frag_tr(Vb, TS, 16 * ks, 32 * d, lane), pf, O[d]); }
        }
        if (it + 1 < ntile) lstore((it + 1) & 1);
        __syncthreads();
    }
    float inv = 1.0f;
    if (!SB) { const float lt = l + __shfl_xor(l, 32); inv = 1.0f / lt; }
    bf16* op = out + (rowb + q0 + r) * DM + ocol;
#pragma unroll
    for (int d = 0; d < 4; ++d)
#pragma unroll
        for (int g = 0; g < 4; ++g) { u32x2 w; w.x = pk2(O[d][4 * g + 0] * inv, O[d][4 * g + 1] * inv); w.y = pk2(O[d][4 * g + 2] * inv, O[d][4 * g + 3] * inv);
            *(u32x2*)(op + 32 * d + 8 * g + 4 * hh) = w; }
}


DI void hgrn_scan16(const float* lfb, size_t row0, int hc, LAS float* tot, int tid, float (&lf)[16], float (&bl)[16], float& blast, float& bref) {
    const int ch = tid & 127, tq = tid >> 7;
    float run = 0.f;
#pragma unroll
    for (int j = 0; j < 16; ++j) { lf[j] = lfb[(row0 + 16 * tq + j) * W_B + hc + ch]; run += lf[j]; bl[j] = run; }
    __syncthreads();
    tot[tq * 128 + ch] = run;
    __syncthreads();
    const float t0 = tot[ch], t1 = tot[128 + ch], t2 = tot[256 + ch], t3 = tot[384 + ch];
    const float base = (tq > 0 ? t0 : 0.f) + (tq > 1 ? t1 : 0.f) + (tq > 2 ? t2 : 0.f);
#pragma unroll
    for (int j = 0; j < 16; ++j) bl[j] += base;
    blast = (t0 + t1) + (t2 + t3); bref = t0 + t1;
}
DI void copy_tile_bf16(LAS unsigned char* dst, const bf16* src, size_t ld, int rows, int tid) {
    for (int c = tid; c < rows * 16; c += NTHREADS) { const int rr = c >> 4, ch = c & 15; *(LAS u32x4*)(dst + rr * TS + ch * 16) = *(const u32x4*)(src + (size_t)rr * ld + ch * 8); }
}
DI void hgrn_local_unit(LAS unsigned char* lds, const float* lfb, const bf16* ibb, float* dS, float* Dc, int unit, const int wv_) {
    const int tid = wv_ * 64 + lane_id_();
    const int lane = tid & 63, wid = __builtin_amdgcn_readfirstlane(tid >> 6), r = lane & 31, hh = lane >> 5;
    const int bh = unit >> 5, c = unit & 31, b = bh >> 3, h = bh & 7, hc = h * 128;
    const size_t row0 = (size_t)b * SEQ + 64 * c;
    LAS unsigned char* KI = lds; LAS unsigned char* IB = lds + 64 * TS; LAS float* tot = (LAS float*)(lds + 2 * 64 * TS);
    float lf[16], bl[16], blast, bref;
    hgrn_scan16(lfb, row0, hc, tot, tid, lf, bl, blast, bref);
    { const int ch = tid & 127, tq = tid >> 7;
#pragma unroll
      for (int j = 0; j < 16; ++j) { const float kk = (1.0f - __expf(lf[j])) * __expf(blast - bl[j]); *(LAS unsigned short*)(KI + (16 * tq + j) * TS + ch * 2) = (unsigned short)f2bf(kk); }
      if (tq == 0) Dc[(size_t)unit * 128 + ch] = __expf(blast); }
    copy_tile_bf16(IB, ibb + row0 * W_B + hc, W_B, 64, tid);
    __syncthreads();
    const int vblk = wid >> 1, cb0 = (wid & 1) * 2;
    f32x16 acc[2] = {zero16(), zero16()};
#pragma unroll
    for (int ks = 0; ks < 4; ++ks) { const bf16x8 af = frag_tr(IB, TS, 16 * ks, 32 * vblk, lane);
#pragma unroll
        for (int cb = 0; cb < 2; ++cb) acc[cb] = MFMA32(af, frag_tr(KI, TS, 16 * ks, 32 * (cb0 + cb), lane), acc[cb]); }
#pragma unroll
    for (int cb = 0; cb < 2; ++cb)
#pragma unroll
        for (int i = 0; i < 16; ++i) { const int v = 32 * vblk + (i & 3) + 8 * (i >> 2) + 4 * hh; dS[((size_t)unit * 128 + v) * 128 + 32 * (cb0 + cb) + r] = acc[cb][i]; }
    __syncthreads();
}
DI void hgrn_scan_phase(const float* dS, const float* Dc, bf16* Sc, float* hs_out, int G, int tid) {
    for (int gid = blockIdx.x * NTHREADS + tid; gid < 32 * 128 * 32; gid += G * NTHREADS) {
        const int bh = gid >> 12, v = (gid >> 5) & 127, c4 = (gid & 31) * 4;
        f32x4 S = (f32x4){0.f, 0.f, 0.f, 0.f};
#pragma unroll 4
        for (int ck = 0; ck < 32; ++ck) { const size_t unit = (size_t)bh * 32 + ck, idx = (unit * 128 + v) * 128 + c4;
            u32x2 w; w.x = pk2(S[0], S[1]); w.y = pk2(S[2], S[3]); *(u32x2*)(Sc + idx) = w;
            const f32x4 d = *(const f32x4*)(Dc + unit * 128 + c4), x = *(const f32x4*)(dS + idx); S = d * S + x; }
#pragma unroll
        for (int e = 0; e < 4; ++e) hs_out[((size_t)bh * 128 + c4 + e) * 128 + v] = S[e];
    }
}
DI void hgrn_out_unit(LAS unsigned char* lds, const float* lfb, const bf16* qbb, const bf16* ibb, const bf16* gbb, const bf16* Sc, bf16* mrg, int unit, const int wv_) {
    const int tid = wv_ * 64 + lane_id_();
    const int lane = tid & 63, wid = __builtin_amdgcn_readfirstlane(tid >> 6), r = lane & 31, hh = lane >> 5;
    const int bh = unit >> 5, c = unit & 31, b = bh >> 3, h = bh & 7, hc = h * 128;
    const size_t row0 = (size_t)b * SEQ + 64 * c;
    LAS unsigned char* QF = lds; LAS unsigned char* QM = lds + 64 * TS; LAS unsigned char* KM = lds + 2 * 64 * TS; LAS unsigned char* IB = lds + 3 * 64 * TS; LAS unsigned char* ST = lds + 4 * 64 * TS;
    LAS float* tot = (LAS float*)(lds + 4 * 64 * TS + 128 * TS); LAS float* red = tot + 512;
    float lf[16], bl[16], blast, bref;
    hgrn_scan16(lfb, row0, hc, tot, tid, lf, bl, blast, bref);
    { const int ch = tid & 127, tq = tid >> 7;
#pragma unroll
      for (int j = 0; j < 16; ++j) { const int t = 16 * tq + j; const float qv = bf2f(qbb[(row0 + t) * W_B + hc + ch]);
          *(LAS unsigned short*)(QF + t * TS + ch * 2) = (unsigned short)f2bf(qv * __expf(bl[j]));
          *(LAS unsigned short*)(QM + t * TS + ch * 2) = (unsigned short)f2bf(qv * __expf(bl[j] - bref));
          *(LAS unsigned short*)(KM + t * TS + ch * 2) = (unsigned short)f2bf((1.0f - __expf(lf[j])) * __expf(bref - bl[j])); } }
    copy_tile_bf16(IB, ibb + row0 * W_B + hc, W_B, 64, tid);
    copy_tile_bf16(ST, Sc + (size_t)unit * 128 * 128, 128, 128, tid);
    __syncthreads();
    const int vblk = wid & 3, tblk = wid >> 2;
    f32x16 SA[2] = {zero16(), zero16()};
#pragma unroll
    for (int sb = 0; sb < 2; ++sb)
#pragma unroll
        for (int ks = 0; ks < 8; ++ks) SA[sb] = MFMA32(frag_row(KM, TS, 32 * sb + pi32(r), 16 * ks, hh), frag_row(QM, TS, 32 * tblk + r, 16 * ks, hh), SA[sb]);
    const int tt = 32 * tblk + r;
#pragma unroll
    for (int sb = 0; sb < 2; ++sb)
#pragma unroll
        for (int i = 0; i < 16; ++i) if (32 * sb + keyloc(i, hh) > tt) SA[sb][i] = 0.f;
    f32x16 O = zero16();
#pragma unroll
    for (int ks = 0; ks < 4; ++ks) O = MFMA32(frag_tr(IB, TS, 16 * ks, 32 * vblk, lane), pack8(SA[ks >> 1], ks & 1), O);
#pragma unroll
    for (int ks = 0; ks < 8; ++ks) O = MFMA32(frag_row(ST, TS, 32 * vblk + r, 16 * ks, hh), frag_row(QF, TS, 32 * tblk + r, 16 * ks, hh), O);
    float ss = 0.f;
#pragma unroll
    for (int i = 0; i < 16; ++i) ss += O[i] * O[i];
    ss += __shfl_xor(ss, 32);
    if (hh == 0) red[vblk * 64 + tt] = ss;
    __syncthreads();
    const float rstd = 1.0f / sqrtf(((red[tt] + red[64 + tt]) + (red[128 + tt] + red[192 + tt])) * (1.0f / 128.0f) + RMS_EPS);
#pragma unroll
    for (int g = 0; g < 4; ++g) { const int v = 32 * vblk + 8 * g + 4 * hh;
        const u32x2 gw = *(const u32x2*)(gbb + (row0 + tt) * W_B + hc + v);
        const float g0 = bf2f((unsigned short)(gw.x & 0xffff)), g1 = bf2f((unsigned short)(gw.x >> 16)), g2 = bf2f((unsigned short)(gw.y & 0xffff)), g3 = bf2f((unsigned short)(gw.y >> 16));
        u32x2 w; w.x = pk2(O[4 * g + 0] * rstd * g0, O[4 * g + 1] * rstd * g1); w.y = pk2(O[4 * g + 2] * rstd * g2, O[4 * g + 3] * rstd * g3);
        *(u32x2*)(mrg + (row0 + tt) * DM + W_A + hc + v) = w; }
    __syncthreads();
}
DI void hgrn_sample_unit(LAS unsigned char* lds, const float* lfb, const bf16* qbb, const bf16* ibb, const bf16* gbb, const float* s0, float* hs_out, bf16* mrg, int unit, const int wv_) {
    const int tid = wv_ * 64 + lane_id_();
    const int b = unit >> 3, h = unit & 7, hc = h * 128;
    const size_t row0 = (size_t)MP + b * 16;
    LAS float* fl = (LAS float*)lds; LAS float* ql = fl + 2048; LAS float* il = ql + 2048; LAS float* part = il + 2048;
    __syncthreads();
    for (int e = tid; e < 2048; e += NTHREADS) { const int t = e >> 7, c = e & 127; const size_t g = (row0 + t) * W_B + hc + c;
        fl[e] = __expf(lfb[g]); ql[e] = bf2f(qbb[g]); il[e] = bf2f(ibb[g]); }
    __syncthreads();
    const int v = tid & 127, cq = tid >> 7;
    float S[32];
#pragma unroll
    for (int j = 0; j < 32; ++j) S[j] = s0[((size_t)unit * 128 + 32 * cq + j) * 128 + v];
#pragma unroll 1
    for (int t = 0; t < 16; ++t) { const float iv = il[t * 128 + v]; float o = 0.f;
#pragma unroll
        for (int j = 0; j < 32; ++j) { const float f = fl[t * 128 + 32 * cq + j]; S[j] = f * S[j] + (1.0f - f) * iv; o += S[j] * ql[t * 128 + 32 * cq + j]; }
        part[(cq * 16 + t) * 128 + v] = o; }
#pragma unroll
    for (int j = 0; j < 32; ++j) hs_out[((size_t)unit * 128 + 32 * cq + j) * 128 + v] = S[j];
    __syncthreads();
    { const int t = tid >> 5, v4 = (tid & 31) * 4; f32x4 o = (f32x4){0.f, 0.f, 0.f, 0.f};
#pragma unroll
      for (int q4 = 0; q4 < 4; ++q4) o += *(const LAS f32x4*)(part + (q4 * 16 + t) * 128 + v4);
      float ss = (o[0] * o[0] + o[1] * o[1]) + (o[2] * o[2] + o[3] * o[3]);
#pragma unroll
      for (int of = 1; of < 32; of <<= 1) ss += __shfl_xor(ss, of);
      const float rstd = 1.0f / sqrtf(ss * (1.0f / 128.0f) + RMS_EPS);
      const size_t g = (row0 + t) * W_B + hc + v4;
      u32x2 w; w.x = pk2(o[0] * rstd * bf2f(gbb[g]), o[1] * rstd * bf2f(gbb[g + 1])); w.y = pk2(o[2] * rstd * bf2f(gbb[g + 2]), o[3] * rstd * bf2f(gbb[g + 3]));
      *(u32x2*)(mrg + (row0 + t) * DM + W_A + hc + v4) = w; }
    __syncthreads();
}


template <bool SB>
DI void attn_sample_unit(LAS unsigned char* lds, const bf16* q, const float* ck, const float* cv, const float* nk, const float* nv, const float* clf, const float* nlf,
                         bf16* out, int b, int h, int H, const int wv_) {
    const int tid = wv_ * 64 + lane_id_();
    const int lane = tid & 63, wid = __builtin_amdgcn_readfirstlane(tid >> 6), r = lane & 31, hh = lane >> 5, t = r & 15;
    const int hcol = h * 128; const size_t stride = (size_t)H * 128;
    LAS float* negc = (LAS float*)lds; LAS float* tmp = negc + 1056; LAS float* Ow = (LAS float*)(lds + 8192); LAS float* mlw = (LAS float*)(lds + 8192 + 65536);
    __syncthreads();
    if (!SB) {
        for (int e = tid; e < 1056; e += NTHREADS) negc[e] = e < 1024 ? clf[((size_t)b * 1024 + e) * H + h] : (e < 1040 ? nlf[((size_t)b * 16 + e - 1024) * H + h] : 0.f);
        __syncthreads();
        block_scan(negc, 1056, tmp, tid);
        for (int e = tid; e < 1056; e += NTHREADS) negc[e] = -negc[e] * LOG2E;
        __syncthreads();
    }
    const size_t qrow = (size_t)MP + b * 16 + t;
    bf16x8 Qf[8];
#pragma unroll
    for (int ks = 0; ks < 8; ++ks) Qf[ks] = *(const bf16x8*)(q + qrow * DM + hcol + 16 * ks + 8 * hh);
    const int blo = (wid * 33) >> 3, bhi = ((wid + 1) * 33) >> 3;
    auto kbase = [&](const float* c, const float* n, int blk) { return blk < 32 ? c + (((size_t)b * 1024 + 32 * blk) * H + h) * 128 : n + (((size_t)b * 16) * H + h) * 128; };
    auto scores = [&](int blk, f32x16& S) {
        const float* kb_ = kbase(ck, nk, blk); const int kmax = blk < 32 ? 31 : 15;
        const int kl = pi32(r); const float* kp = kb_ + (size_t)(kl < kmax ? kl : kmax) * stride + 8 * hh;
#pragma unroll
        for (int ks = 0; ks < 8; ++ks) { const f32x4 a = *(const f32x4*)(kp + 16 * ks), c = *(const f32x4*)(kp + 16 * ks + 4);
            u32x4 p; p[0] = pk2(a[0], a[1]); p[1] = pk2(a[2], a[3]); p[2] = pk2(c[0], c[1]); p[3] = pk2(c[2], c[3]);
            S = MFMA32(__builtin_bit_cast(bf16x8, p), Qf[ks], S); } };
    auto pv = [&](int blk, const f32x16& P, f32x16 (&O)[4]) {
        const float* vb_ = kbase(cv, nv, blk); const int kmax = blk < 32 ? 31 : 15;
#pragma unroll
        for (int s = 0; s < 2; ++s) { const bf16x8 pf = pack8(P, s);
#pragma unroll
            for (int d = 0; d < 4; ++d) { float x[8];
#pragma unroll
                for (int j = 0; j < 8; ++j) { const int kl = 16 * s + 8 * hh + j; x[j] = vb_[(size_t)(kl < kmax ? kl : kmax) * stride + 32 * d + r]; }
                u32x4 p; p[0] = pk2(x[0], x[1]); p[1] = pk2(x[2], x[3]); p[2] = pk2(x[4], x[5]); p[3] = pk2(x[6], x[7]);
                O[d] = MFMA32(__builtin_bit_cast(bf16x8, p), pf, O[d]); } } };
    f32x16 O[4] = {zero16(), zero16(), zero16(), zero16()};
    if (!SB) {
        float m = -INFINITY, l = 0.f;
        for (int blk = blo; blk < bhi; ++blk) {
            f32x16 S;
#pragma unroll
            for (int g = 0; g < 2; ++g) { const f32x4 c0 = *(const LAS f32x4*)(negc + 32 * blk + 16 * g + 8 * hh), c1 = *(const LAS f32x4*)(negc + 32 * blk + 16 * g + 8 * hh + 4);
                S[8 * g + 0] = c0[0]; S[8 * g + 1] = c0[1]; S[8 * g + 2] = c0[2]; S[8 * g + 3] = c0[3]; S[8 * g + 4] = c1[0]; S[8 * g + 5] = c1[1]; S[8 * g + 6] = c1[2]; S[8 * g + 7] = c1[3]; }
            scores(blk, S);
            float mx = -INFINITY;
#pragma unroll
            for (int i = 0; i < 16; ++i) { const int key = 32 * blk + keyloc(i, hh); if (key > 1024 + t) S[i] = -INFINITY; mx = fmaxf(mx, S[i]); }
            mx = fmaxf(mx, __shfl_xor(mx, 32));
            const float mn = fmaxf(m, mx), corr = fexp2(m - mn); float ps = 0.f;
#pragma unroll
            for (int i = 0; i < 16; ++i) { S[i] = fexp2(S[i] - mn); ps += S[i]; }
            l = l * corr + ps; m = mn;
#pragma unroll
            for (int d = 0; d < 4; ++d) O[d] = O[d] * corr;
            pv(blk, S, O);
        }
        l += __shfl_xor(l, 32);
        if (lane < 16) { mlw[wid * 16 + lane] = m; mlw[128 + wid * 16 + lane] = l; }
    } else {
        float tot = 0.f;
        for (int blk = blo; blk < bhi; ++blk) { f32x16 S = zero16(); scores(blk, S);
#pragma unroll
            for (int i = 0; i < 16; ++i) { const int key = 32 * blk + keyloc(i, hh); const float z = S[i]; if (key < 1024 + t) tot += -(fmaxf(z, 0.f) + flog2(1.0f + fexp2(-fabsf(z)))); } }
        tot += __shfl_xor(tot, 32);
        if (lane < 16) mlw[256 + wid * 16 + lane] = tot;
        __syncthreads();
        float carry = 0.f;
        for (int w = wid + 1; w < 8; ++w) carry += mlw[256 + w * 16 + t];
        for (int blk = bhi - 1; blk >= blo; --blk) { f32x16 S = zero16(), L; scores(blk, S);
            float G[2], Go[2];
#pragma unroll
            for (int g = 0; g < 2; ++g) { float gs = 0.f;
#pragma unroll
                for (int j = 0; j < 8; ++j) { const int i = 8 * g + j; const float z = S[i]; const bool ok = (32 * blk + keyloc(i, hh)) < 1024 + t;
                    const float lsm = ok ? -(fmaxf(z, 0.f) + flog2(1.0f + fexp2(-fabsf(z)))) : 0.f; L[i] = lsm; S[i] = ok ? z : -INFINITY; gs += lsm; }
                G[g] = gs; }
            Go[0] = __shfl_xor(G[0], 32); Go[1] = __shfl_xor(G[1], 32);
            float above = carry;
#pragma unroll
            for (int u = 1; u >= 0; --u) { float run = above + (hh == 0 ? Go[u] : 0.f);
#pragma unroll
                for (int j = 7; j >= 0; --j) { const int i = 8 * u + j; run += L[i]; S[i] = fexp2(S[i] + run); }
                above += G[u] + Go[u]; }
            carry = above;
            pv(blk, S, O);
        }
    }
    if (r < 16) {
#pragma unroll
        for (int d = 0; d < 4; ++d)
#pragma unroll
            for (int i = 0; i < 16; ++i) Ow[(wid * 128 + 32 * d + (i & 3) + 8 * (i >> 2) + 4 * hh) * 16 + r] = O[d][i];
    }
    __syncthreads();
    { const int tq = tid >> 5, d4 = (tid & 31) * 4; float sc[8]; float Lt = 1.0f;
      if (!SB) { float M = -INFINITY;
#pragma unroll
          for (int w = 0; w < 8; ++w) M = fmaxf(M, mlw[w * 16 + tq]);
          Lt = 0.f;
#pragma unroll
          for (int w = 0; w < 8; ++w) { sc[w] = fexp2(mlw[w * 16 + tq] - M); Lt += mlw[128 + w * 16 + tq] * sc[w]; }
          Lt = 1.0f / Lt; }
      else {
#pragma unroll
          for (int w = 0; w < 8; ++w) sc[w] = 1.0f; }
      float o[4] = {0.f, 0.f, 0.f, 0.f};
#pragma unroll
      for (int w = 0; w < 8; ++w)
#pragma unroll
          for (int e = 0; e < 4; ++e) o[e] += Ow[(w * 128 + d4 + e) * 16 + tq] * sc[w];
      u32x2 wv; wv.x = pk2(o[0] * Lt, o[1] * Lt); wv.y = pk2(o[2] * Lt, o[3] * Lt);
      *(u32x2*)(out + ((size_t)MP + b * 16 + tq) * DM + hcol + d4) = wv; }
    __syncthreads();
}

struct FMemKV { float* ok; float* ov; bf16* kb;
    DI void apply4(const pg8::Unit&, int row, int col, f32x4 v) const {
        if (col < DM) { *(f32x4*)(ok + (size_t)row * DM + col) = v; u32x2 w; w.x = pk2(v[0], v[1]); w.y = pk2(v[2], v[3]); *(u32x2*)(kb + (size_t)row * DM + col) = w; }
        else { *(f32x4*)(ov + (size_t)row * DM + (col - DM)) = v; }
    } };
struct FBf16 { bf16* o; int ld; float sc;
    DI void apply4(const pg8::Unit&, int row, int col, f32x4 v) const { u32x2 w; w.x = pk2(v[0] * sc, v[1] * sc); w.y = pk2(v[2] * sc, v[3] * sc); *(u32x2*)(o + (size_t)row * ld + col) = w; } };


struct FSwiglu { bf16* h;
    DI void pair4(int row, int hc, f32x4 g, f32x4 u) const { u32x2 w; w.x = pk2(siluf_(g[0]) * u[0], siluf_(g[1]) * u[1]); w.y = pk2(siluf_(g[2]) * u[2], siluf_(g[3]) * u[3]);
        *(u32x2*)(h + (size_t)row * D_FF + hc) = w; } };
struct FResid { float* x32; float sc;
    DI void apply4(const pg8::Unit&, int row, int col, f32x4 v) const { float* p = x32 + (size_t)row * DM + col; const f32x4 r = *(const f32x4*)p; *(f32x4*)p = r * ALPHA + v * sc; } };
constexpr float QS128 = 0.08838834764831845f * LOG2E;
constexpr float QS512 = 0.04419417382415922f * LOG2E;
struct FEvenIn { float* out; unsigned char* ws; const float *b_f, *lbl, *ng;
    DI void apply4(const pg8::Unit&, int row, int col, f32x4 v) const {
        const int seg = col >> 10, c = col & 1023; const bool smp = row >= MP;
        if (seg == 0) { u32x2 w; w.x = pk2(v[0] * QS128, v[1] * QS128); w.y = pk2(v[2] * QS128, v[3] * QS128); *(u32x2*)((bf16*)(ws + WS_Q) + (size_t)row * DM + c) = w; }
        else if (seg == 1 || seg == 2) {
            const size_t oo = smp ? (seg == 1 ? O_FKS : O_FVS) + (size_t)(row - MP) * W_A + c : (seg == 1 ? O_FK : O_FV) + (size_t)row * W_A + c;
            *(f32x4*)(out + oo) = v;
            if (!smp) { u32x2 w; w.x = pk2(v[0], v[1]); w.y = pk2(v[2], v[3]); *(u32x2*)((bf16*)(ws + (seg == 1 ? WS_KB : WS_VB)) + (size_t)row * DM + c) = w; }
        } else if (seg == 3) { u32x2 w; w.x = pk2(siluf_(v[0]), siluf_(v[1])); w.y = pk2(siluf_(v[2]), siluf_(v[3])); *(u32x2*)((bf16*)(ws + WS_QBB) + (size_t)row * W_B + c) = w; }
        else if (seg == 4) { const f32x4 l0 = *(const f32x4*)(lbl + c), l1 = *(const f32x4*)(lbl + W_B + c); f32x4 r;
#pragma unroll
            for (int e = 0; e < 4; ++e) { const float lb = 1.0f / (1.0f + __expf(l1[e] - l0[e])); r[e] = __logf(lb + (1.0f - lb) * sigmoidf_(v[e])); }
            *(f32x4*)((float*)(ws + WS_LFB) + (size_t)row * W_B + c) = r; }
        else if (seg == 5) { u32x2 w; w.x = pk2(v[0], v[1]); w.y = pk2(v[2], v[3]); *(u32x2*)((bf16*)(ws + WS_IBB) + (size_t)row * W_B + c) = w; }
        else if (seg == 6) { const f32x4 g = *(const f32x4*)(ng + c); u32x2 w; w.x = pk2(g[0] * siluf_(v[0]), g[1] * siluf_(v[1])); w.y = pk2(g[2] * siluf_(v[2]), g[3] * siluf_(v[3])); *(u32x2*)((bf16*)(ws + WS_GBB) + (size_t)row * W_B + c) = w; }
        else if (c < 8) { const f32x4 b = *(const f32x4*)(b_f + c); f32x4 r;
#pragma unroll
            for (int e = 0; e < 4; ++e) r[e] = logsigmoidf_(v[e] + b[e]);
            const size_t oo = smp ? O_FLFS + (size_t)(row - MP) * H_A + c : O_FLF + (size_t)row * H_A + c;
            *(f32x4*)(out + oo) = r; }
    } };
struct FOddIn { float* out; unsigned char* ws;
    DI void apply4(const pg8::Unit&, int row, int col, f32x4 v) const {
        const int seg = col >> 11, c = col & 2047; const bool smp = row >= MP;
        if (seg == 0) { u32x2 w; w.x = pk2(v[0] * QS128, v[1] * QS128); w.y = pk2(v[2] * QS128, v[3] * QS128); *(u32x2*)((bf16*)(ws + WS_Q) + (size_t)row * DM + c) = w; }
        else { const size_t oo = smp ? (seg == 1 ? O_SKS : O_SVS) + (size_t)(row - MP) * W_C + c : (seg == 1 ? O_SK : O_SV) + (size_t)row * W_C + c;
            *(f32x4*)(out + oo) = v;
            if (!smp) { u32x2 w; w.x = pk2(v[0], v[1]); w.y = pk2(v[2], v[3]); *(u32x2*)((bf16*)(ws + (seg == 1 ? WS_KB : WS_VB)) + (size_t)row * DM + c) = w; } }
    } };
struct CrossSOrder { const bf16* Q; const bf16* Kmem; int lda, ldb, G, c;
    DI bool next(int i, pg8::Unit& u) const { const int L = i * G + c; if (L >= 128) return false; u.z = L >> 3; u.pm = L & 7; u.pn = 0; return true; }
    DI const char* pa(const pg8::Unit& u) const { return (const char*)(Q + ((size_t)(u.z >> 2) * SEQ + 256 * u.pm) * DM + (u.z & 3) * HD_X); }
    DI const char* pb(const pg8::Unit& u) const { return (const char*)(Kmem + ((size_t)(u.z >> 2) * N_MEM) * DM + (u.z & 3) * HD_X); } };
struct CrossOOrder { const bf16* P; const bf16* VT; int lda, ldb, G, c;
    DI bool next(int i, pg8::Unit& u) const { const int L = i * G + c; if (L >= 256) return false; u.z = L >> 4; u.pm = (L >> 1) & 7; u.pn = L & 1; return true; }
    DI const char* pa(const pg8::Unit& u) const { return (const char*)(P + ((size_t)(u.z >> 2) * SEQ + 256 * u.pm) * 1024 + (u.z & 3) * N_MEM); }
    DI const char* pb(const pg8::Unit& u) const { return (const char*)(VT + ((size_t)(u.z & 3) * HD_X + 256 * u.pn) * 1024 + (u.z >> 2) * N_MEM); } };
struct FCrossO { bf16* o;
    DI void apply4(const pg8::Unit& u, int row, int col, f32x4 v) const { u32x2 w; w.x = pk2(v[0], v[1]); w.y = pk2(v[2], v[3]);
        *(u32x2*)(o + ((size_t)(u.z >> 2) * SEQ + row) * DM + (u.z & 3) * HD_X + col) = w; } };
struct EpiSoftmax {
    static constexpr bool AFTER_DRAIN = true;
    bf16* P;
    DI void fused(f32x4 (&acc)[2][2][4][2], const pg8::Unit& u, int wr, int wc, int fr, int fq, LAS unsigned char* lds, int wid, int lane) const {
        LAS float* MX = (LAS float*)lds; LAS float* SM = MX + 1024;
        float rm[2][4];
#pragma unroll
        for (int ai = 0; ai < 2; ++ai)
#pragma unroll
            for (int m = 0; m < 4; ++m) { float mx = -INFINITY;
#pragma unroll
                for (int bj = 0; bj < 2; ++bj)
#pragma unroll
                    for (int n = 0; n < 2; ++n) { const f32x4 x = acc[ai][bj][m][n]; mx = fmaxf(mx, fmaxf(fmaxf(x[0], x[1]), fmaxf(x[2], x[3]))); }
                mx = fmaxf(mx, __shfl_xor(mx, 16)); mx = fmaxf(mx, __shfl_xor(mx, 32));
                if (fq == 0) MX[(ai * 128 + wr * 64 + m * 16 + fr) * 4 + wc] = mx; }
        __syncthreads();
#pragma unroll
        for (int ai = 0; ai < 2; ++ai)
#pragma unroll
            for (int m = 0; m < 4; ++m) { const f32x4 q4 = *(const LAS f32x4*)(MX + (ai * 128 + wr * 64 + m * 16 + fr) * 4); const float M = fmaxf(fmaxf(q4[0], q4[1]), fmaxf(q4[2], q4[3])); float s = 0.f;
#pragma unroll
                for (int bj = 0; bj < 2; ++bj)
#pragma unroll
                    for (int n = 0; n < 2; ++n) { f32x4 x = acc[ai][bj][m][n]; x[0] = fexp2(x[0] - M); x[1] = fexp2(x[1] - M); x[2] = fexp2(x[2] - M); x[3] = fexp2(x[3] - M); acc[ai][bj][m][n] = x; s += (x[0] + x[1]) + (x[2] + x[3]); }
                s += __shfl_xor(s, 16); s += __shfl_xor(s, 32);
                if (fq == 0) SM[(ai * 128 + wr * 64 + m * 16 + fr) * 4 + wc] = s; rm[ai][m] = 0.f; }
        __syncthreads();
#pragma unroll
        for (int ai = 0; ai < 2; ++ai)
#pragma unroll
            for (int m = 0; m < 4; ++m) { const int rl = ai * 128 + wr * 64 + m * 16 + fr; const f32x4 q4 = *(const LAS f32x4*)(SM + rl * 4); const float inv = 1.0f / ((q4[0] + q4[1]) + (q4[2] + q4[3]));
                bf16* pr = P + ((size_t)(u.z >> 2) * SEQ + 256 * u.pm + rl) * 1024 + (u.z & 3) * N_MEM;
#pragma unroll
                for (int bj = 0; bj < 2; ++bj)
#pragma unroll
                    for (int n = 0; n < 2; ++n) { const f32x4 x = acc[ai][bj][m][n] * inv; u32x2 w; w.x = pk2(x[0], x[1]); w.y = pk2(x[2], x[3]); *(u32x2*)(pr + bj * 128 + wc * 32 + n * 16 + 4 * fq) = w; } }
        (void)rm; (void)wid; (void)lane;
    }
};
DI void cross_sample_unit(LAS unsigned char* lds, const bf16* q, const float* mk, const float* mv, bf16* out, int b, int hx, const int wv_) {
    const int tid = wv_ * 64 + lane_id_();
    const int lane = tid & 63, wid = __builtin_amdgcn_readfirstlane(tid >> 6), r = lane & 31, hh = lane >> 5, t = r & 15;
    LAS float* Ow = (LAS float*)(lds + 8192); LAS float* mlw = (LAS float*)lds;
    const float* kp = mk + ((size_t)b * N_MEM + 32 * wid + pi32(r)) * DM + hx * HD_X + 8 * hh;
    const bf16* qp = q + ((size_t)MP + b * 16 + t) * DM + hx * HD_X + 8 * hh;
    __syncthreads();
    f32x16 S = zero16();
#pragma unroll 8
    for (int ks = 0; ks < 32; ++ks) { const f32x4 a = *(const f32x4*)(kp + 16 * ks), c = *(const f32x4*)(kp + 16 * ks + 4);
        u32x4 p; p[0] = pk2(a[0], a[1]); p[1] = pk2(a[2], a[3]); p[2] = pk2(c[0], c[1]); p[3] = pk2(c[2], c[3]);
        S = MFMA32(__builtin_bit_cast(bf16x8, p), *(const bf16x8*)(qp + 16 * ks), S); }
    float mx = S[0];
#pragma unroll
    for (int i = 1; i < 16; ++i) mx = fmaxf(mx, S[i]);
    mx = fmaxf(mx, __shfl_xor(mx, 32));
    if (lane < 16) mlw[wid * 16 + lane] = mx;
    __syncthreads();
    float M = -INFINITY;
#pragma unroll
    for (int w = 0; w < 8; ++w) M = fmaxf(M, mlw[w * 16 + t]);
    float ps = 0.f;
#pragma unroll
    for (int i = 0; i < 16; ++i) { S[i] = fexp2(S[i] - M); ps += S[i]; }
    ps += __shfl_xor(ps, 32);
    if (lane < 16) mlw[128 + wid * 16 + lane] = ps;
    const bf16x8 pf0 = pack8(S, 0), pf1 = pack8(S, 1);
    const float* vp = mv + ((size_t)b * N_MEM + 32 * wid) * DM + hx * HD_X + r;
#pragma unroll 1
    for (int pass = 0; pass < 4; ++pass) {
        f32x16 O[4] = {zero16(), zero16(), zero16(), zero16()};
#pragma unroll
        for (int s = 0; s < 2; ++s)
#pragma unroll
            for (int d = 0; d < 4; ++d) { float x[8];
#pragma unroll
                for (int j = 0; j < 8; ++j) x[j] = vp[(size_t)(16 * s + 8 * hh + j) * DM + 128 * pass + 32 * d];
                u32x4 p; p[0] = pk2(x[0], x[1]); p[1] = pk2(x[2], x[3]); p[2] = pk2(x[4], x[5]); p[3] = pk2(x[6], x[7]);
                O[d] = MFMA32(__builtin_bit_cast(bf16x8, p), s == 0 ? pf0 : pf1, O[d]); }
        __syncthreads();
        if (r < 16) {
#pragma unroll
            for (int d = 0; d < 4; ++d)
#pragma unroll
                for (int i = 0; i < 16; ++i) Ow[(wid * 128 + 32 * d + (i & 3) + 8 * (i >> 2) + 4 * hh) * 16 + r] = O[d][i]; }
        __syncthreads();
        { const int tq = tid >> 5, d4 = (tid & 31) * 4; float Lt = 0.f;
#pragma unroll
          for (int w = 0; w < 8; ++w) Lt += mlw[128 + w * 16 + tq];
          Lt = 1.0f / Lt; float o[4] = {0.f, 0.f, 0.f, 0.f};
#pragma unroll
          for (int w = 0; w < 8; ++w)
#pragma unroll
              for (int e = 0; e < 4; ++e) o[e] += Ow[(w * 128 + d4 + e) * 16 + tq];
          u32x2 wv; wv.x = pk2(o[0] * Lt, o[1] * Lt); wv.y = pk2(o[2] * Lt, o[3] * Lt);
          *(u32x2*)(out + ((size_t)MP + b * 16 + tq) * DM + hx * HD_X + 128 * pass + d4) = wv; }
    }
    __syncthreads();
}

DI void ln_phase(float* x32, bf16* xb, const float* g, const float* b, float* yout, int gw, int NGW, int lane) {
    for (int row = gw; row < MT; row += NGW) {
        float* xr = x32 + (size_t)row * DM;
        f32x4 v[8]; float s = 0.f;
#pragma unroll
        for (int j = 0; j < 8; ++j) { v[j] = *(const f32x4*)(xr + (lane + 64 * j) * 4); s += (v[j][0] + v[j][1]) + (v[j][2] + v[j][3]); }
        const float mean = wave_sum(s) * (1.0f / DM); float s2 = 0.f;
#pragma unroll
        for (int j = 0; j < 8; ++j) { v[j] = v[j] - mean; s2 += (v[j][0] * v[j][0] + v[j][1] * v[j][1]) + (v[j][2] * v[j][2] + v[j][3] * v[j][3]); }
        const float rstd = 1.0f / sqrtf(wave_sum(s2) * (1.0f / DM) + LN_EPS);
#pragma unroll
        for (int j = 0; j < 8; ++j) { const int cc = (lane + 64 * j) * 4; const f32x4 gg = *(const f32x4*)(g + cc), bb = *(const f32x4*)(b + cc);
            const f32x4 y = v[j] * rstd * gg + bb; *(f32x4*)(xr + cc) = y;
            u32x2 w; w.x = pk2(y[0], y[1]); w.y = pk2(y[2], y[3]); *(u32x2*)(xb + (size_t)row * DM + cc) = w;
            if (yout) *(f32x4*)(yout + (size_t)row * DM + cc) = y; }
    }
}

struct Args { const float* in[29]; float* out; unsigned char* ws; int ph_lo, ph_hi; };

template <int MODE>
DI int wmap(int n) {
    if (MODE == 1) return (n >> 7) * 256 + (n & 127);
    if (MODE == 2) return (n >> 7) * 256 + 128 + (n & 127);
    if (MODE == 3) return n < 3072 ? n : (n < 3080 ? 7168 + (n - 3072) : n - 8);
    return n;
}
template <int MODE>
DI void transpose_item(const float* W, int K, int N, bf16* WT, LAS float* scr, int item, int lane) {
    const int nblk = (N + 31) / 32, kb = item / nblk, nb = item % nblk, k0 = 64 * kb, n0 = 32 * nb;
    const int nn = n0 + (lane & 31);
#pragma unroll 8
    for (int i = 0; i < 32; ++i) { const int kk = 2 * i + (lane >> 5); scr[kk * 33 + (lane & 31)] = (nn < N) ? W[(size_t)(k0 + kk) * N + nn] : 0.f; }
    LDS_WAIT(); asm volatile("" ::: "memory");
    const int c = lane & 7;
#pragma unroll
    for (int j = 0; j < 4; ++j) { const int n = (lane >> 3) + 8 * j; const LAS float* s = scr + (8 * c) * 33 + n;
        u32x4 o; o.x = pk2(s[0 * 33], s[1 * 33]); o.y = pk2(s[2 * 33], s[3 * 33]); o.z = pk2(s[4 * 33], s[5 * 33]); o.w = pk2(s[6 * 33], s[7 * 33]);
        if (n0 + n < N) *(u32x4*)(WT + (size_t)wmap<MODE>(n0 + n) * K + k0 + 8 * c) = o; }
    LDS_WAIT(); asm volatile("" ::: "memory");
}

DI bool in_phase_(int lo, int hi, int k) { asm volatile("" : "+s"(lo), "+s"(hi)); return lo <= k && k < hi; }
#define IN(k) in_phase_(lo, hi, (k))
#define SEAM(k) do { if (IN(k) && IN((k) + 1)) xcd_barrier(bar); } while (0)
#define PH_BEGIN const int lane = lane_id_(); const int tid = wave * 64 + lane; (void)tid; GAS unsigned char* ws_g = (GAS unsigned char*)args.ws; asm volatile("" : "+s"(ws_g)); unsigned char* ws = (unsigned char*)ws_g; GAS float* out_g = (GAS float*)args.out; asm volatile("" : "+s"(out_g)); float* outp = (float*)out_g; \
    bf16* Wgu = (bf16*)(ws + WS_WGU); bf16* Wd = (bf16*)(ws + WS_WD); bf16* Wq = (bf16*)(ws + WS_WQ); bf16* Wkv = (bf16*)(ws + WS_WKV); bf16* Wo = (bf16*)(ws + WS_WO); \
    bf16* WinE = (bf16*)(ws + WS_WINE); bf16* WoutE = (bf16*)(ws + WS_WOUTE); bf16* WinO = (bf16*)(ws + WS_WINO); bf16* WoutO = (bf16*)(ws + WS_WOUTO); \
    float* x32 = (float*)(ws + WS_X32); bf16* xb = (bf16*)(ws + WS_XB); \
    bf16* memb = (bf16*)(ws + WS_MEMB); bf16* memK = (bf16*)(ws + WS_MEMK); bf16* memVT = (bf16*)(ws + WS_MEMVT); \
    bf16* hbuf = (bf16*)(ws + WS_H); bf16* mrg = (bf16*)(ws + WS_MRG); bf16* qbuf = (bf16*)(ws + WS_Q); bf16* kbuf = (bf16*)(ws + WS_KB); bf16* vbuf = (bf16*)(ws + WS_VB); \
    bf16* qbb = (bf16*)(ws + WS_QBB); bf16* ibb = (bf16*)(ws + WS_IBB); bf16* gbb = (bf16*)(ws + WS_GBB); float* lfb = (float*)(ws + WS_LFB); \
    (void)Wgu; (void)Wd; (void)Wq; (void)Wkv; (void)Wo; (void)WinE; (void)WoutE; (void)WinO; (void)WoutO; (void)x32; (void)xb; (void)memb; (void)memK; (void)memVT; \
    (void)hbuf; (void)mrg; (void)qbuf; (void)kbuf; (void)vbuf; (void)qbb; (void)ibb; (void)gbb; (void)lfb; (void)outp;
#define INP(k) ({ GAS const float* _p = (GAS const float*)args.in[k]; asm volatile("" : "+s"(_p)); (const float*)_p; })

template <int l>
DI void layer_body(const Args& args, LAS unsigned char* lds, const int wave, const int G, const int lo, const int hi, const XcdBarrier& bar) {
    const int gw = blockIdx.x * NWAVES + wave, NGW = G * NWAVES;
    const int pb = 2 + l * PH_PER_LAYER;
        if (IN(pb + 0)) {
            PH_BEGIN
            const bf16* W = Wgu + (size_t)(2 * l) * NGU * DM;
            { pg8::GridOrder S; S.init(xb, DM, W, DM, 32, 43, G, (int)blockIdx.x); pg8::EpiPair<FSwiglu> E{{hbuf}}; pg8::gemm_phase(lds, S, DM, E, wave); }
            skinny_phase<true>(lds, xb + (size_t)MP * DM, DM, W, DM, DM, 344, FSwiglu{hbuf}, wave);
        }
        SEAM(pb + 0);
        if (IN(pb + 1)) {
            PH_BEGIN
            const bf16* W = Wd + (size_t)(2 * l) * DM * D_FF;
            { pg8::GridOrder S; S.init(hbuf, D_FF, W, D_FF, 32, 8, G, (int)blockIdx.x); pg8::EpiEach<FResid> E{{x32, 0.5f}}; pg8::gemm_phase(lds, S, D_FF, E, wave); }
            skinny_phase<false>(lds, hbuf + (size_t)MP * D_FF, D_FF, W, D_FF, D_FF, 64, FResid{x32, 0.5f}, wave);
        }
        SEAM(pb + 1);
        if (IN(pb + 2)) { PH_BEGIN ln_phase(x32, xb, INP(11) + (size_t)(l * 4 + 0) * DM, INP(12) + (size_t)(l * 4 + 0) * DM, nullptr, gw, NGW, lane); }
        SEAM(pb + 2);
        if (IN(pb + 3)) {
            PH_BEGIN
            if constexpr (l == 0) {
                const FEvenIn f{outp, ws, INP(23), INP(24), INP(25)};
                { pg8::GridOrder S; S.init(xb, DM, WinE, DM, 32, 29, G, (int)blockIdx.x); pg8::EpiEach<FEvenIn> E{f}; pg8::gemm_phase(lds, S, DM, E, wave); }
                skinny_phase<false>(lds, xb + (size_t)MP * DM, DM, WinE, DM, DM, 232, f, wave);
            } else {
                const FOddIn f{outp, ws};
                { pg8::GridOrder S; S.init(xb, DM, WinO, DM, 32, 24, G, (int)blockIdx.x); pg8::EpiEach<FOddIn> E{f}; pg8::gemm_phase(lds, S, DM, E, wave); }
                skinny_phase<false>(lds, xb + (size_t)MP * DM, DM, WinO, DM, DM, 192, f, wave);
            }
        }
        SEAM(pb + 3);
        if (IN(pb + 4)) {
            PH_BEGIN
            const int cu = (int)blockIdx.x, rc = G - 1 - cu;
            if constexpr (l == 0) {
                LAS float* negc = (LAS float*)lds; LAS float* stmp = (LAS float*)(lds + 8192);
#pragma unroll 1
                for (int u = cu; u < 256; u += G) {
                    const int qb = 7 - (u >> 5), bh = u & 31, b = bh >> 3, h = bh & 7;
                    __syncthreads();
                    for (int e = tid; e < 512; e += NTHREADS) { f32x4 a;
#pragma unroll
                        for (int k4 = 0; k4 < 4; ++k4) a[k4] = outp[O_FLF + ((size_t)b * SEQ + 4 * e + k4) * H_A + h];
                        *(LAS f32x4*)(negc + 4 * e) = a; }
                    __syncthreads();
                    block_scan(negc, 2048, stmp, tid);
                    for (int e = tid; e < 2048; e += NTHREADS) negc[e] = -negc[e] * LOG2E;
                    __syncthreads();
                    attn_prompt_unit<false>(lds, qbuf, kbuf, vbuf, mrg, b, h * 128, h * 128, qb, negc, wave);
                }
                __syncthreads();
#pragma unroll 1
                for (int u = cu; u < 1024; u += G) hgrn_local_unit(lds, lfb, ibb, (float*)(ws + WS_DS), (float*)(ws + WS_DC), u, wave);
#pragma unroll 1
                for (int u = rc; u < 64; u += G) attn_sample_unit<false>(lds, qbuf, INP(3), INP(4), outp + O_FKS, outp + O_FVS, INP(5), outp + O_FLFS, mrg, u >> 3, u & 7, H_A, wave);
#pragma unroll 1
                for (int u = rc - 64; u >= 0 && u < 64; u += G) hgrn_sample_unit(lds, lfb, qbb, ibb, gbb, INP(6), outp + O_HSS, mrg, u, wave);
            } else {
#pragma unroll 1
                for (int u = cu; u < 512; u += G) {
                    const int uu = u & 255, bh = uu & 63, qb = u < 256 ? 7 - (uu >> 6) : (uu >> 6);
                    attn_prompt_unit<true>(lds, qbuf, kbuf, vbuf, mrg, bh >> 4, (bh & 15) * 128, (bh & 15) * 128, qb, nullptr, wave);
                }
#pragma unroll 1
                for (int u = rc; u < 128; u += G) attn_sample_unit<true>(lds, qbuf, INP(7), INP(8), outp + O_SKS, outp + O_SVS, nullptr, nullptr, mrg, u >> 4, u & 15, H_C, wave);
            }
        }
        SEAM(pb + 4);
        if (IN(pb + 5)) { PH_BEGIN if constexpr (l == 0) hgrn_scan_phase((const float*)(ws + WS_DS), (const float*)(ws + WS_DC), (bf16*)(ws + WS_SC), outp + O_HS, G, tid); }
        SEAM(pb + 5);
        if (IN(pb + 6)) { PH_BEGIN if constexpr (l == 0) {
#pragma unroll 1
            for (int u = (int)blockIdx.x; u < 1024; u += G) hgrn_out_unit(lds, lfb, qbb, ibb, gbb, (const bf16*)(ws + WS_SC), mrg, u, wave); } }
        SEAM(pb + 6);
        if (IN(pb + 7)) {
            PH_BEGIN
            const bf16* W = l == 0 ? WoutE : WoutO;
            { pg8::GridOrder S; S.init(mrg, DM, W, DM, 32, 8, G, (int)blockIdx.x); pg8::EpiEach<FResid> E{{x32, 1.0f}}; pg8::gemm_phase(lds, S, DM, E, wave); }
            skinny_phase<false>(lds, mrg + (size_t)MP * DM, DM, W, DM, DM, 64, FResid{x32, 1.0f}, wave);
        }
        SEAM(pb + 7);
        if (IN(pb + 8)) { PH_BEGIN ln_phase(x32, xb, INP(11) + (size_t)(l * 4 + 1) * DM, INP(12) + (size_t)(l * 4 + 1) * DM, nullptr, gw, NGW, lane); }
        SEAM(pb + 8);
        if (IN(pb + 9)) {
            PH_BEGIN
            const bf16* W = Wq + (size_t)l * DM * DM;
            { pg8::GridOrder S; S.init(xb, DM, W, DM, 32, 8, G, (int)blockIdx.x); pg8::EpiEach<FBf16> E{{qbuf, DM, QS512}}; pg8::gemm_phase(lds, S, DM, E, wave); }
            skinny_phase<false>(lds, xb + (size_t)MP * DM, DM, W, DM, DM, 64, FBf16{qbuf, DM, QS512}, wave);
        }
        SEAM(pb + 9);
        if (IN(pb + 10)) {
            PH_BEGIN
            { CrossSOrder S{qbuf, memK + (size_t)l * 1024 * DM, DM, DM, G, (int)blockIdx.x}; EpiSoftmax E{(bf16*)(ws + WS_P)}; pg8::gemm_phase(lds, S, HD_X, E, wave); }
#pragma unroll 1
            for (int u = G - 1 - (int)blockIdx.x; u < 32; u += G)
                cross_sample_unit(lds, qbuf, INP(9) + (size_t)l * DEC_B * N_MEM * DM, INP(10) + (size_t)l * DEC_B * N_MEM * DM, mrg, u >> 2, u & 3, wave);
        }
        SEAM(pb + 10);
        if (IN(pb + 11)) {
            PH_BEGIN
            CrossOOrder S{(const bf16*)(ws + WS_P), memVT + (size_t)l * DM * 1024, 1024, 1024, G, (int)blockIdx.x}; pg8::EpiEach<FCrossO> E{{mrg}}; pg8::gemm_phase(lds, S, N_MEM, E, wave);
        }
        SEAM(pb + 11);
        if (IN(pb + 12)) {
            PH_BEGIN
            const bf16* W = Wo + (size_t)l * DM * DM;
            { pg8::GridOrder S; S.init(mrg, DM, W, DM, 32, 8, G, (int)blockIdx.x); pg8::EpiEach<FResid> E{{x32, 1.0f}}; pg8::gemm_phase(lds, S, DM, E, wave); }
            skinny_phase<false>(lds, mrg + (size_t)MP * DM, DM, W, DM, DM, 64, FResid{x32, 1.0f}, wave);
        }
        SEAM(pb + 12);
        if (IN(pb + 13)) { PH_BEGIN ln_phase(x32, xb, INP(11) + (size_t)(l * 4 + 2) * DM, INP(12) + (size_t)(l * 4 + 2) * DM, nullptr, gw, NGW, lane); }
        SEAM(pb + 13);
        if (IN(pb + 14)) {
            PH_BEGIN
            const bf16* W = Wgu + (size_t)(2 * l + 1) * NGU * DM;
            { pg8::GridOrder S; S.init(xb, DM, W, DM, 32, 43, G, (int)blockIdx.x); pg8::EpiPair<FSwiglu> E{{hbuf}}; pg8::gemm_phase(lds, S, DM, E, wave); }
            skinny_phase<true>(lds, xb + (size_t)MP * DM, DM, W, DM, DM, 344, FSwiglu{hbuf}, wave);
        }
        SEAM(pb + 14);
        if (IN(pb + 15)) {
            PH_BEGIN
            const bf16* W = Wd + (size_t)(2 * l + 1) * DM * D_FF;
            { pg8::GridOrder S; S.init(hbuf, D_FF, W, D_FF, 32, 8, G, (int)blockIdx.x); pg8::EpiEach<FResid> E{{x32, 0.5f}}; pg8::gemm_phase(lds, S, D_FF, E, wave); }
            skinny_phase<false>(lds, hbuf + (size_t)MP * D_FF, D_FF, W, D_FF, D_FF, 64, FResid{x32, 0.5f}, wave);
        }
        SEAM(pb + 15);
        if (IN(pb + 16)) { PH_BEGIN ln_phase(x32, xb, INP(11) + (size_t)(l * 4 + 3) * DM, INP(12) + (size_t)(l * 4 + 3) * DM, l == 1 ? outp + O_Y : nullptr, gw, NGW, lane); }
        SEAM(pb + 16);
    }
__global__ void __launch_bounds__(NTHREADS, 2) fwd(Args args) {
    extern __shared__ __attribute__((aligned(16))) unsigned char lds_raw[];
    LAS unsigned char* lds = (LAS unsigned char*)lds_raw;
    const int tid0 = threadIdx.x, wave = __builtin_amdgcn_readfirstlane(tid0 >> 6);
    const int G = gridDim.x;
    unsigned* ctl = (unsigned*)(args.ws + WS_CTL);
    volatile LAS unsigned* MISC = (volatile LAS unsigned*)(lds + MISC_OFF);
    for (int u = tid0; u < (LDS_BYTES - RING_BYTES) / 4; u += NTHREADS) ((LAS unsigned*)(lds + RING_BYTES))[u] = 0u;
    __syncthreads();
    const int lo = args.ph_lo, hi = args.ph_hi;
    const bool multi = (hi - lo) > 1;
    XcdBarrier bar; bar.bar = ctl + CW_BAR; bar.x = 0; bar.st = nullptr;
    if (multi) bar = xcd_barrier_post(ctl + CW_BAR, MISC + 8);
    bar.wv = wave;

    const int gw = blockIdx.x * NWAVES + wave, NGW = G * NWAVES;
    if (IN(0)) {
        PH_BEGIN
        LAS float* scr = (LAS float*)(lds + wave * 16384);
        constexpr int I_GU = 32 * 172, I_D = 86 * 64, I_22 = 32 * 64, I_KV = 32 * 128, I_INE = 32 * 225, I_INO = 32 * 192;
        constexpr int PER_L = 6 * I_GU + 2 * I_22 + I_KV;
        constexpr int NITEMS = 2 * PER_L + I_INE + I_22 + I_INO + I_22;
        static_assert(I_GU == I_D, "items");
#pragma unroll 1
        for (int it = gw; it < NITEMS; it += NGW) {
            int r = it;
            if (r < 2 * PER_L) {
                const int l = r / PER_L; r -= l * PER_L;
                if (r < I_GU) { transpose_item<1>(INP(13) + (size_t)l * DM * D_FF, DM, D_FF, Wgu + (size_t)(2 * l) * NGU * DM, scr, r, lane); continue; } r -= I_GU;
                if (r < I_GU) { transpose_item<2>(INP(14) + (size_t)l * DM * D_FF, DM, D_FF, Wgu + (size_t)(2 * l) * NGU * DM, scr, r, lane); continue; } r -= I_GU;
                if (r < I_D) { transpose_item<0>(INP(15) + (size_t)l * DM * D_FF, D_FF, DM, Wd + (size_t)(2 * l) * DM * D_FF, scr, r, lane); continue; } r -= I_D;
                if (r < I_GU) { transpose_item<1>(INP(16) + (size_t)l * DM * D_FF, DM, D_FF, Wgu + (size_t)(2 * l + 1) * NGU * DM, scr, r, lane); continue; } r -= I_GU;
                if (r < I_GU) { transpose_item<2>(INP(17) + (size_t)l * DM * D_FF, DM, D_FF, Wgu + (size_t)(2 * l + 1) * NGU * DM, scr, r, lane); continue; } r -= I_GU;
                if (r < I_D) { transpose_item<0>(INP(18) + (size_t)l * DM * D_FF, D_FF, DM, Wd + (size_t)(2 * l + 1) * DM * D_FF, scr, r, lane); continue; } r -= I_D;
                if (r < I_22) { transpose_item<0>(INP(19) + (size_t)l * DM * DM, DM, DM, Wq + (size_t)l * DM * DM, scr, r, lane); continue; } r -= I_22;
                if (r < I_KV) { transpose_item<0>(INP(20) + (size_t)l * DM * 2 * DM, DM, 2 * DM, Wkv + (size_t)l * 2 * DM * DM, scr, r, lane); continue; } r -= I_KV;
                transpose_item<0>(INP(21) + (size_t)l * DM * DM, DM, DM, Wo + (size_t)l * DM * DM, scr, r, lane); continue;
            }
            r -= 2 * PER_L;
            if (r < I_INE) { transpose_item<3>(INP(22), DM, D_IN_EVEN, WinE, scr, r, lane); continue; } r -= I_INE;
            if (r < I_22) { transpose_item<0>(INP(26), DM, DM, WoutE, scr, r, lane); continue; } r -= I_22;
            if (r < I_INO) { transpose_item<0>(INP(27), DM, D_IN_ODD, WinO, scr, r, lane); continue; } r -= I_INO;
            transpose_item<0>(INP(28), DM, DM, WoutO, scr, r, lane);
        }
        for (int i = gw * 64 + lane; i < (NE - D_IN_EVEN) * DM / 8; i += NGW * 64) *(u32x4*)(WinE + (size_t)D_IN_EVEN * DM + (size_t)i * 8) = (u32x4){0u, 0u, 0u, 0u};
#pragma unroll 1
        for (int m = gw; m < MT + 1024; m += NGW) {
            const float* src; float* d32 = nullptr; bf16* d16;
            if (m < MP) { src = INP(0) + (size_t)m * DM; d32 = x32 + (size_t)m * DM; d16 = xb + (size_t)m * DM; }
            else if (m < MT) { src = INP(1) + (size_t)(m - MP) * DM; d32 = x32 + (size_t)m * DM; d16 = xb + (size_t)m * DM; }
            else { src = INP(2) + (size_t)(m - MT) * DM; d16 = memb + (size_t)(m - MT) * DM; }
#pragma unroll
            for (int j = 0; j < 8; ++j) { const f32x4 v = *(const f32x4*)(src + (lane + 64 * j) * 4); if (d32) *(f32x4*)(d32 + (lane + 64 * j) * 4) = v;
                u32x2 w; w.x = pk2(v[0], v[1]); w.y = pk2(v[2], v[3]); *(u32x2*)(d16 + (lane + 64 * j) * 4) = w; }
        }
    }
    SEAM(0);
    if (IN(1)) {
        PH_BEGIN
#pragma unroll 1
        for (int l = 0; l < 2; ++l) {
            { pg8::GridOrder S; S.init(memb, DM, Wkv + (size_t)l * 2 * DM * DM, DM, 4, 16, G, (int)blockIdx.x);
              pg8::EpiEach<FMemKV> E{{outp + O_MK + (size_t)l * 1024 * DM, outp + O_MV + (size_t)l * 1024 * DM, memK + (size_t)l * 1024 * DM}};
              pg8::gemm_phase(lds, S, DM, E, wave); }
            { pg8::GridOrder S; S.init(Wkv + (size_t)l * 2 * DM * DM + (size_t)DM * DM, DM, memb, DM, 8, 4, G, (int)blockIdx.x);
              pg8::EpiEach<FBf16> E{{memVT + (size_t)l * DM * 1024, 1024, 1.0f}};
              pg8::gemm_phase(lds, S, DM, E, wave); }
        }
    }
    SEAM(1);
    layer_body<0>(args, lds, wave, G, lo, hi, bar);
    layer_body<1>(args, lds, wave, G, lo, hi, bar);
#undef IN
#undef SEAM
}

constexpr int N_PHASES = 2 + 2 * PH_PER_LAYER;

extern "C" void kernel_launch(void* const* d_in, const int* in_sizes, int n_in, void* d_out, int out_size, void* d_ws, size_t ws_size, hipStream_t stream) {
    static int grid = 0;
    if (grid == 0) {
        if (n_in != 29 || (size_t)out_size != O_END || ws_size < WS_END) { fprintf(stderr, "kernel_launch: unexpected sizes n_in %d out %d ws %zu (need %zu)\n", n_in, out_size, ws_size, (size_t)WS_END); grid = -1; return; }
        int dev = 0, cus = 0, per_cu = 0;
        if (hipGetDevice(&dev) != hipSuccess || hipDeviceGetAttribute(&cus, hipDeviceAttributeMultiprocessorCount, dev) != hipSuccess) { grid = -1; return; }
        if (hipFuncSetAttribute((const void*)fwd, hipFuncAttributeMaxDynamicSharedMemorySize, LDS_BYTES) != hipSuccess) { fprintf(stderr, "kernel_launch: hipFuncSetAttribute failed\n"); grid = -1; return; }
        if (hipOccupancyMaxActiveBlocksPerMultiprocessor(&per_cu, (const void*)fwd, NTHREADS, LDS_BYTES) != hipSuccess || per_cu < 1) fprintf(stderr, "kernel_launch: occupancy query says %d\n", per_cu);
        (void)hipGetLastError();
        grid = cus;
    }
    if (grid < 0) return;
    (void)hipMemsetAsync((char*)d_ws + WS_CTL, 0, CTL_ZERO_BYTES, stream);
    Args a{};
    for (int i = 0; i < 29; ++i) a.in[i] = (const float*)d_in[i];
    a.out = (float*)d_out; a.ws = (unsigned char*)d_ws;
#ifndef ONE_LAUNCH
    for (int p = 0; p < N_PHASES; ++p) { a.ph_lo = p; a.ph_hi = p + 1; hipLaunchKernelGGL(fwd, dim3(grid), dim3(NTHREADS), LDS_BYTES, stream, a); }
#else
    a.ph_lo = 0; a.ph_hi = N_PHASES; hipLaunchKernelGGL(fwd, dim3(grid), dim3(NTHREADS), LDS_BYTES, stream, a);
#endif
}
```

```cpp
#include <hip/hip_runtime.h>
#include <cstdio>
#include <cstdint>

#define LAS __attribute__((address_space(3)))
#define GAS __attribute__((address_space(1)))
typedef unsigned short bf16;
typedef short bf16x8 __attribute__((ext_vector_type(8)));
typedef short s16x4 __attribute__((ext_vector_type(4)));
typedef float f32x4 __attribute__((ext_vector_type(4)));
typedef float f32x2 __attribute__((ext_vector_type(2)));
typedef float f32x16 __attribute__((ext_vector_type(16)));
typedef unsigned u32x4 __attribute__((ext_vector_type(4)));
typedef unsigned u32x2 __attribute__((ext_vector_type(2)));
#define DI __device__ __forceinline__
__device__ __forceinline__ int lane_id_() { int l; asm volatile("v_mbcnt_lo_u32_b32 %0, -1, 0\n\tv_mbcnt_hi_u32_b32 %0, -1, %0" : "=v"(l)); return l; }

constexpr int DM = 2048, BATCH = 4, SEQ = 2048, DEC_B = 8, DEC_T = 16, PAST = 1024;
constexpr int MP = BATCH * SEQ;
constexpr int MS = DEC_B * DEC_T;
constexpr int MT = MP + MS;
constexpr int HD = 128, H_A = 8, W_A = 1024, H_B = 8, W_B = 1024, H_C = 16, W_C = 2048, H_X = 4, HD_X = 512, N_MEM = 256;
constexpr int D_FF = 5504, NGU = 2 * D_FF;
constexpr int D_IN_EVEN = 7176, NE = 7424;
constexpr int D_IN_ODD = 6144;
constexpr float ALPHA = 1.41421356237309515f;
constexpr float LN_EPS = 1e-5f, RMS_EPS = 1e-6f;
constexpr float LOG2E = 1.4426950408889634f, LN2 = 0.6931471805599453f;

constexpr size_t O_Y = 0, O_YS = O_Y + (size_t)MP * DM, O_FK = O_YS + (size_t)MS * DM, O_FV = O_FK + (size_t)MP * W_A, O_FLF = O_FV + (size_t)MP * W_A,
    O_HS = O_FLF + (size_t)MP * H_A, O_SK = O_HS + (size_t)BATCH * H_B * 128 * 128, O_SV = O_SK + (size_t)MP * W_C, O_MK = O_SV + (size_t)MP * W_C,
    O_MV = O_MK + (size_t)2 * BATCH * N_MEM * DM, O_FKS = O_MV + (size_t)2 * BATCH * N_MEM * DM, O_FVS = O_FKS + (size_t)MS * W_A, O_FLFS = O_FVS + (size_t)MS * W_A,
    O_HSS = O_FLFS + (size_t)MS * H_A, O_SKS = O_HSS + (size_t)DEC_B * H_B * 128 * 128, O_SVS = O_SKS + (size_t)MS * W_C, O_END = O_SVS + (size_t)MS * W_C;

constexpr size_t MiB = 1u << 20;
constexpr size_t al(size_t x) { return (x + 255) & ~(size_t)255; }
constexpr size_t WS_CTL = 0, CTL_ZERO_BYTES = 1 * MiB;
constexpr size_t SZ_WGU = (size_t)NGU * DM * 2, SZ_WD = (size_t)DM * D_FF * 2, SZ_W22 = (size_t)DM * DM * 2, SZ_WKV = (size_t)2 * DM * DM * 2;
constexpr size_t WS_WGU = 2 * MiB;
constexpr size_t WS_WD = WS_WGU + 4 * SZ_WGU;
constexpr size_t WS_WQ = WS_WD + 4 * SZ_WD;
constexpr size_t WS_WKV = WS_WQ + 2 * SZ_W22;
constexpr size_t WS_WO = WS_WKV + 2 * SZ_WKV;
constexpr size_t WS_WINE = WS_WO + 2 * SZ_W22;
constexpr size_t WS_WOUTE = WS_WINE + (size_t)NE * DM * 2;
constexpr size_t WS_WINO = WS_WOUTE + SZ_W22;
constexpr size_t WS_WOUTO = WS_WINO + (size_t)D_IN_ODD * DM * 2;
constexpr size_t WS_X32 = al(WS_WOUTO + SZ_W22);
constexpr size_t WS_XB = al(WS_X32 + (size_t)MT * DM * 4);
constexpr size_t WS_H = al(WS_XB + (size_t)MT * DM * 2);
constexpr size_t WS_MRG = al(WS_H + (size_t)MT * D_FF * 2);
constexpr size_t WS_Q = al(WS_MRG + (size_t)MT * DM * 2);
constexpr size_t WS_KB = al(WS_Q + (size_t)MT * DM * 2);
constexpr size_t WS_VB = al(WS_KB + (size_t)MP * DM * 2);
constexpr size_t WS_QBB = al(WS_VB + (size_t)MP * DM * 2);
constexpr size_t WS_IBB = al(WS_QBB + (size_t)MT * W_B * 2);
constexpr size_t WS_GBB = al(WS_IBB + (size_t)MT * W_B * 2);
constexpr size_t WS_LFB = al(WS_GBB + (size_t)MT * W_B * 2);
constexpr size_t WS_MEMB = al(WS_LFB + (size_t)MT * W_B * 4);
constexpr size_t WS_MEMK = al(WS_MEMB + (size_t)1024 * DM * 2);
constexpr size_t WS_MEMVT = al(WS_MEMK + (size_t)2 * 1024 * DM * 2);
constexpr size_t WS_P = al(WS_MEMVT + (size_t)2 * 1024 * DM * 2);
constexpr size_t WS_DS = al(WS_P + (size_t)MP * 1024 * 2);
constexpr size_t WS_DC = al(WS_DS + (size_t)1024 * 128 * 128 * 4);
constexpr size_t WS_SC = al(WS_DC + (size_t)1024 * 128 * 4);
constexpr size_t WS_END = al(WS_SC + (size_t)1024 * 128 * 128 * 2);

constexpr int CW_TMO = 0;
constexpr int CW_BAR = 4096;

constexpr int RING_BYTES = 131072;
constexpr int MISC_OFF = RING_BYTES + 320;
constexpr int LDS_BYTES = 147456;
constexpr int NWAVES = 8, NTHREADS = 512;
constexpr int PH_PER_LAYER = 17;
constexpr int N_PHASES_DBG = 2 + 2 * PH_PER_LAYER;

#define LDS_WAIT() asm volatile("s_waitcnt lgkmcnt(0)" ::: "memory")
#define VM_WAIT() asm volatile("s_waitcnt vmcnt(0)" ::: "memory")
DI unsigned f2bf(float f) { unsigned u = __builtin_bit_cast(unsigned, f); return (u + 0x7fffu + ((u >> 16) & 1u)) >> 16; }
DI unsigned pk2(float lo, float hi) { unsigned r; asm volatile("v_cvt_pk_bf16_f32 %0, %1, %2" : "=v"(r) : "v"(lo), "v"(hi)); return r; }
DI float bf2f(unsigned short b) { return __builtin_bit_cast(float, (unsigned)b << 16); }
DI float wave_sum(float v) {
#pragma unroll
    for (int o = 1; o < 64; o <<= 1) v += __shfl_xor(v, o);
    return v;
}
DI float fexp2(float x) { return __builtin_amdgcn_exp2f(x); }
DI float flog2(float x) { return __builtin_amdgcn_logf(x); }
DI float sigmoidf_(float x) { return 1.0f / (1.0f + __expf(-x)); }
DI float siluf_(float x) { return x / (1.0f + __expf(-x)); }
DI float logsigmoidf_(float x) { return fminf(x, 0.f) - log1pf(__expf(-fabsf(x))); }

#define XB_TMO      128
#define XB_XCNT(j)  (256  + 64 * (j))
#define XB_XSUB(j)  (1280 + 64 * (j))
#define XB_XGEN(j)  (2304 + 64 * (j))
#define XB_TOP      3328
#define XB_TOPGEN   3392
#define XCD_BAR_WORDS 3456
#define XB_SPIN_CAP (1u << 18)
__device__ __forceinline__ unsigned xb_ld(unsigned* p)              { return __hip_atomic_load(p, __ATOMIC_RELAXED, __HIP_MEMORY_SCOPE_AGENT); }
__device__ __forceinline__ unsigned xb_add(unsigned* p, unsigned v) { return __hip_atomic_fetch_add(p, v, __ATOMIC_RELAXED, __HIP_MEMORY_SCOPE_AGENT); }
__device__ __forceinline__ unsigned xb_xcc_id() { return (unsigned)__builtin_amdgcn_s_getreg((3 << 11) | 20) & 0xFu; }
#define XB_SPIN(cond, bar) do { unsigned _sp = 0; while (cond) { __builtin_amdgcn_s_sleep(1); \
    if ((++_sp & 255u) == 0u) { if (xb_ld(&(bar)[XB_TMO])) break; if (_sp > XB_SPIN_CAP) { atomicAdd(&(bar)[XB_TMO], 1u); break; } } } } while (0)
struct XcdBarrier { unsigned* bar; unsigned x; volatile LAS unsigned* st; int wv; };
__device__ __forceinline__ XcdBarrier xcd_barrier_post(unsigned* bar, volatile LAS unsigned* st) {
    XcdBarrier b; b.bar = bar; b.x = xb_xcc_id(); b.st = st;
    if (threadIdx.x == 0) (void)xb_add(&bar[XB_XCNT(b.x)], 1u);
    return b;
}
__device__ __forceinline__ void xcd_barrier_complete(unsigned* bar, unsigned x, unsigned& nloc, unsigned& nx) {
    const unsigned G = gridDim.x * gridDim.y * gridDim.z;
    unsigned sum, cnt, mine, sp = 0u;
    for (;;) {
        sum = 0u; cnt = 0u; mine = 0u;
#pragma unroll
        for (unsigned j = 0; j < 16; ++j) { const unsigned c = xb_ld(&bar[XB_XCNT(j)]); sum += c; cnt += (c > 0u) ? 1u : 0u; mine = (j == x) ? c : mine; }
        if (sum == G) break;
        __builtin_amdgcn_s_sleep(1);
        if ((++sp & 255u) == 0u) { if (xb_ld(&bar[XB_TMO])) break; if (sp > XB_SPIN_CAP) { atomicAdd(&bar[XB_TMO], 1u); break; } }
    }
    nloc = mine > 0u ? mine : 1u; nx = cnt > 0u ? cnt : 1u;
}
__device__ __forceinline__ void xcd_barrier(const XcdBarrier& b) {
    asm volatile("s_waitcnt vmcnt(0)" ::: "memory");
    __syncthreads();
    if (b.wv == 0 && lane_id_() == 0) {
        size_t zb = 0; asm volatile("" : "+s"(zb)); unsigned* bar = b.bar + zb;
        __builtin_amdgcn_s_waitcnt(0);
        unsigned nloc = b.st[0], nx = b.st[1];
        unsigned bx = b.x; asm volatile("" : "+s"(bx));
        if (nloc == 0u) { xcd_barrier_complete(bar, bx, nloc, nx); b.st[0] = nloc; b.st[1] = nx; }
        const unsigned old = xb_add(&bar[XB_XSUB(bx)], 1u);
        const unsigned gen = old / nloc;
        if (old + 1u == (gen + 1u) * nloc) {
            __builtin_amdgcn_fence(__ATOMIC_RELEASE, "agent");
            asm volatile("s_waitcnt vmcnt(0)" ::: "memory");
            const unsigned og = xb_add(&bar[XB_TOP], 1u);
            const unsigned tg = og / nx;
            if (og + 1u == (tg + 1u) * nx) xb_add(&bar[XB_TOPGEN], 1u);
            else XB_SPIN(xb_ld(&bar[XB_TOPGEN]) == tg, bar);
            __builtin_amdgcn_fence(__ATOMIC_ACQUIRE, "agent");
            xb_add(&bar[XB_XGEN(bx)], 1u);
            asm volatile("s_waitcnt vmcnt(0)" ::: "memory");
        } else {
            XB_SPIN(xb_ld(&bar[XB_XGEN(bx)]) == gen, bar);
            __builtin_amdgcn_fence(__ATOMIC_ACQUIRE, "agent");
            asm volatile("s_waitcnt vmcnt(0)" ::: "memory");
        }
    }
    __syncthreads();
}

namespace pg8 {
constexpr int BM = 256, BK = 64, HALF = 128, HTB = HALF * BK * 2, STAGE_BYTES = 8 * HTB, NXCD = 8, WGM = 8;
DI int lds_byte(int r, int c) { const int st = (r >> 4) * 2 + (c >> 5), rr = r & 15, cc = c & 31, ob = rr * 64 + cc * 2; return st * 1024 + (ob ^ (((ob >> 9) & 1) << 5)); }
DI void stage_rc(int b, int& R, int& C) { const int st = b / 1024, sb = b % 1024, swz = sb ^ (((sb >> 9) & 1) << 5); R = (st >> 1) * 16 + swz / 64; C = (st & 1) * 32 + (swz % 64) / 2; }
struct Unit { int pm, pn, z; };
struct GridOrder {
    const bf16* A; const bf16* Bt; int lda, ldb; int nM, nN, nwg, G, c;
    DI void init(const bf16* A_, int lda_, const bf16* Bt_, int ldb_, int nM_, int nN_, int G_, int c_) { A = A_; Bt = Bt_; lda = lda_; ldb = ldb_; nM = nM_; nN = nN_; nwg = nM * nN; G = G_; c = c_; }
    DI bool next(int i, Unit& u) const {
        const long L = (long)i * G + c; if (L >= nwg) return false;
        int wgid = (int)L; { const int q = nwg / NXCD, r = nwg % NXCD, xcd = wgid % NXCD, off = wgid / NXCD; wgid = (xcd < r ? xcd * (q + 1) : r * (q + 1) + (xcd - r) * q) + off; }
        const int nig = WGM * nN, gid = wgid / nig, fm = gid * WGM, gsz = (nM - fm) < WGM ? (nM - fm) : WGM;
        u.pm = fm + ((wgid % nig) % gsz); u.pn = (wgid % nig) / gsz; u.z = 0; return true;
    }
    DI const char* pa(const Unit& u) const { return (const char*)(A + (size_t)u.pm * 256 * lda); }
    DI const char* pb(const Unit& u) const { return (const char*)(Bt + (size_t)u.pn * 256 * ldb); }
};

template <class Epi, class Sched>
__device__ __forceinline__ void gemm_phase(LAS unsigned char* lds, const Sched& S, const int K, const Epi& E, const int wv_) {
    const int tid = wv_ * 64 + lane_id_();
    const int wid = __builtin_amdgcn_readfirstlane(tid >> 6), lane = tid & 63, wr = wid >> 2, wc = wid & 3, fr = lane & 15, fq = lane >> 4;
    const int nt = K / BK;
    const int lda = S.lda, ldb = S.ldb;
    unsigned voffA[2], voffB[2];
#pragma unroll
    for (int i = 0; i < 2; ++i) { int R, C; stage_rc(tid * 16 + i * 8192, R, C);
        voffA[i] = (unsigned)(R * lda + C) * 2u; voffB[i] = (unsigned)(R * ldb + C) * 2u; }
    const size_t kstep = (size_t)(BK * 2);
    const size_t hstepA = (size_t)HALF * lda * 2, hstepB = (size_t)HALF * ldb * 2;
    const unsigned ldsw = (unsigned)wid * 1024u;
    const int aoff = lds_byte(wr * 64 + fr, fq * 8), boff = lds_byte(wc * 32 + fr, fq * 8);
#define PG8_SA(b, h) (((b) * 2 + (h)) * HTB)
#define PG8_SB(b, h) ((4 + (b) * 2 + (h)) * HTB)
#define PG8_STAGE(bufoff, gbase, voff) do { _Pragma("unroll") for (int _i = 0; _i < 2; ++_i) \
        __builtin_amdgcn_global_load_lds((const unsigned*)((const char*)(gbase) + (voff)[_i]), (LAS unsigned*)(lds + (bufoff) + ldsw + _i * 8192), 16, 0, 0); } while (0)
#define PG8_LDA(dst, b, h) do { _Pragma("unroll") for (int m = 0; m < 4; ++m) _Pragma("unroll") for (int k = 0; k < 2; ++k) dst[m][k] = *(const LAS bf16x8*)(lds + PG8_SA(b, h) + aoff + m * 2048 + k * 1024); } while (0)
#define PG8_LDB(dst, b, h) do { _Pragma("unroll") for (int n = 0; n < 2; ++n) _Pragma("unroll") for (int k = 0; k < 2; ++k) dst[n][k] = *(const LAS bf16x8*)(lds + PG8_SB(b, h) + boff + n * 2048 + k * 1024); } while (0)
#define PG8_MMA(ai, bj, At, Bt) do { __builtin_amdgcn_s_setprio(1); _Pragma("unroll") for (int m = 0; m < 4; ++m) _Pragma("unroll") for (int n = 0; n < 2; ++n) _Pragma("unroll") for (int k = 0; k < 2; ++k) \
        acc[ai][bj][m][n] = __builtin_amdgcn_mfma_f32_16x16x32_bf16(Bt[n][k], At[m][k], acc[ai][bj][m][n], 0, 0, 0); __builtin_amdgcn_s_setprio(0); } while (0)
#define PG8_WAIT_V(n) asm volatile("s_waitcnt vmcnt(" #n ")" ::: "memory")
#define PG8_WAIT_L(n) asm volatile("s_waitcnt lgkmcnt(" #n ")" ::: "memory")
#define PG8_BAR __builtin_amdgcn_s_barrier()
#define PG8_SCHED __builtin_amdgcn_sched_barrier(0)
    Unit cur, nxt; int ui = 0;
    if (!S.next(0, cur)) return;
    f32x4 acc[2][2][4][2];
#pragma unroll
    for (int a = 0; a < 2; ++a)
#pragma unroll
        for (int b = 0; b < 2; ++b)
#pragma unroll
            for (int m = 0; m < 4; ++m)
#pragma unroll
                for (int n = 0; n < 2; ++n) acc[a][b][m][n] = (f32x4){0.f, 0.f, 0.f, 0.f};
    bf16x8 At[4][2], B0[2][2], B1[2][2];
    const char* cA = S.pa(cur); const char* cB = S.pb(cur);
    {
        PG8_STAGE(PG8_SB(0, 0), cB, voffB); PG8_STAGE(PG8_SB(0, 1), cB + hstepB, voffB); PG8_STAGE(PG8_SA(0, 0), cA, voffA); PG8_STAGE(PG8_SA(0, 1), cA + hstepA, voffA);
        if (wr == 1) PG8_BAR;
        PG8_WAIT_V(2); PG8_BAR;
        PG8_STAGE(PG8_SB(1, 0), cB + kstep, voffB); PG8_STAGE(PG8_SA(1, 0), cA + kstep, voffA); PG8_STAGE(PG8_SB(1, 1), cB + hstepB + kstep, voffB);
        PG8_WAIT_V(6); PG8_BAR;
    }
    for (;;) {
        const bool has_next = S.next(ui + 1, nxt);
        const char* nA = has_next ? S.pa(nxt) : cA; const char* nB = has_next ? S.pb(nxt) : cB;
        for (int t = 0; t < nt; t += 2) {
            const bool last = (t == nt - 2);
            const char* a1 = cA + (size_t)(t + 1) * kstep;
            const char* a2 = last ? nA : cA + (size_t)(t + 2) * kstep; const char* b2 = last ? nB : cB + (size_t)(t + 2) * kstep;
            const char* a3 = a2 + kstep; const char* b3 = b2 + kstep;
            PG8_LDB(B0, 0, 0); PG8_LDB(B1, 0, 1); PG8_SCHED; PG8_LDA(At, 0, 0); PG8_STAGE(PG8_SA(1, 1), a1 + hstepA, voffA);
            PG8_WAIT_V(8); PG8_WAIT_L(0); PG8_BAR; PG8_MMA(0, 0, At, B0); PG8_MMA(0, 1, At, B1); PG8_BAR; PG8_SCHED;
            PG8_LDA(At, 0, 1); PG8_STAGE(PG8_SB(0, 0), b2, voffB); PG8_STAGE(PG8_SB(0, 1), b2 + hstepB, voffB); PG8_STAGE(PG8_SA(0, 0), a2, voffA);
            PG8_WAIT_V(8); PG8_WAIT_L(0); PG8_BAR; PG8_MMA(1, 0, At, B0); PG8_MMA(1, 1, At, B1); PG8_BAR; PG8_SCHED;
            PG8_LDB(B0, 1, 0); PG8_LDB(B1, 1, 1); PG8_SCHED; PG8_LDA(At, 1, 0); PG8_STAGE(PG8_SA(0, 1), a2 + hstepA, voffA);
            PG8_WAIT_V(8); PG8_WAIT_L(0); PG8_BAR; PG8_MMA(0, 0, At, B0); PG8_MMA(0, 1, At, B1); PG8_BAR; PG8_SCHED;
            PG8_LDA(At, 1, 1); PG8_STAGE(PG8_SB(1, 0), b3, voffB); PG8_STAGE(PG8_SB(1, 1), b3 + hstepB, voffB); PG8_STAGE(PG8_SA(1, 0), a3, voffA);
            PG8_WAIT_V(8); PG8_WAIT_L(0); PG8_BAR; PG8_MMA(1, 0, At, B0); PG8_MMA(1, 1, At, B1); PG8_BAR; PG8_SCHED;
        }
        if (wr == 0) PG8_BAR;
        if constexpr (!Epi::AFTER_DRAIN) { E(acc, cur, wr, wc, fr, fq); }
        if (!has_next) break;
#pragma unroll
        for (int a = 0; a < 2; ++a)
#pragma unroll
            for (int b = 0; b < 2; ++b)
#pragma unroll
                for (int m = 0; m < 4; ++m)
#pragma unroll
                    for (int n = 0; n < 2; ++n) acc[a][b][m][n] = (f32x4){0.f, 0.f, 0.f, 0.f};
        cur = nxt; cA = nA; cB = nB; ++ui;
        if (wr == 1) PG8_BAR;
    }
    PG8_WAIT_V(0);
    PG8_BAR;
    if constexpr (Epi::AFTER_DRAIN) { E.fused(acc, cur, wr, wc, fr, fq, lds, wid, lane); }
#undef PG8_SA
#undef PG8_SB
#undef PG8_STAGE
#undef PG8_LDA
#undef PG8_LDB
#undef PG8_MMA
#undef PG8_WAIT_V
#undef PG8_WAIT_L
#undef PG8_BAR
#undef PG8_SCHED
}

template <class F> struct EpiEach {
    static constexpr bool AFTER_DRAIN = false;
    F f;
    DI void operator()(const f32x4 (&acc)[2][2][4][2], const Unit& u, int wr, int wc, int fr, int fq) const {
#pragma unroll
        for (int ai = 0; ai < 2; ++ai)
#pragma unroll
            for (int m = 0; m < 4; ++m) { const int row = u.pm * BM + ai * HALF + wr * 64 + m * 16 + fr;
#pragma unroll
                for (int bj = 0; bj < 2; ++bj)
#pragma unroll
                    for (int n = 0; n < 2; ++n) f.apply4(u, row, u.pn * BM + bj * HALF + wc * 32 + n * 16 + 4 * fq, acc[ai][bj][m][n]);
                asm volatile("" ::: "memory"); }
    }
};
template <class F> struct EpiPair {
    static constexpr bool AFTER_DRAIN = false;
    F f;
    DI void operator()(const f32x4 (&acc)[2][2][4][2], const Unit& u, int wr, int wc, int fr, int fq) const {
#pragma unroll
        for (int ai = 0; ai < 2; ++ai)
#pragma unroll
            for (int m = 0; m < 4; ++m) { const int row = u.pm * BM + ai * HALF + wr * 64 + m * 16 + fr;
#pragma unroll
                for (int n = 0; n < 2; ++n) f.pair4(row, u.pn * HALF + wc * 32 + n * 16 + 4 * fq, acc[ai][0][m][n], acc[ai][1][m][n]);
                asm volatile("" ::: "memory"); }
    }
};
}

template <bool PAIR, class F>
__device__ __forceinline__ void skinny_phase(LAS unsigned char* lds, const bf16* A, int lda, const bf16* Bt, int ldb, int K, int nunits, const F& f, const int wv_) {
    const int tid = wv_ * 64 + lane_id_();
    const int wid = __builtin_amdgcn_readfirstlane(tid >> 6), lane = tid & 63, l15 = lane & 15, lq = lane >> 4;
    const int G = gridDim.x, c = (int)blockIdx.x;
    const int nks = K / 32, ks0 = (wid * nks) / 8, ks1 = ((wid + 1) * nks) / 8;
    for (int j = G - 1 - c; j < nunits; j += G) {
        int c0, c1;
        if (PAIR) { c0 = (j >> 3) * 256 + (j & 7) * 16; c1 = c0 + 128; } else { c0 = 32 * j; c1 = c0 + 16; }
        f32x4 acc[2][8];
#pragma unroll
        for (int nb = 0; nb < 2; ++nb)
#pragma unroll
            for (int i = 0; i < 8; ++i) acc[nb][i] = (f32x4){0.f, 0.f, 0.f, 0.f};
        const bf16* w0 = Bt + (size_t)(c0 + l15) * ldb + lq * 8;
        const bf16* w1 = Bt + (size_t)(c1 + l15) * ldb + lq * 8;
        const bf16* ap = A + (size_t)l15 * lda + lq * 8;
#pragma unroll 2
        for (int ks = ks0; ks < ks1; ++ks) {
            const bf16x8 wa = *(const bf16x8*)(w0 + ks * 32), wb = *(const bf16x8*)(w1 + ks * 32);
            bf16x8 xa[8];
#pragma unroll
            for (int i = 0; i < 8; ++i) xa[i] = *(const bf16x8*)(ap + (size_t)(16 * i) * lda + ks * 32);
#pragma unroll
            for (int i = 0; i < 8; ++i) { acc[0][i] = __builtin_amdgcn_mfma_f32_16x16x32_bf16(wa, xa[i], acc[0][i], 0, 0, 0); acc[1][i] = __builtin_amdgcn_mfma_f32_16x16x32_bf16(wb, xa[i], acc[1][i], 0, 0, 0); }
        }
        __syncthreads();
#pragma unroll
        for (int nb = 0; nb < 2; ++nb)
#pragma unroll
            for (int i = 0; i < 8; ++i) *(LAS f32x4*)(lds + ((((wid * 2 + nb) * 8 + i) * 64 + lane) * 16)) = acc[nb][i];
        __syncthreads();
        {
            const int i = tid >> 6, lp = tid & 63;
            f32x4 v0 = (f32x4){0.f, 0.f, 0.f, 0.f}, v1 = v0;
#pragma unroll
            for (int w = 0; w < 8; ++w) { v0 += *(const LAS f32x4*)(lds + ((((w * 2 + 0) * 8 + i) * 64 + lp) * 16)); v1 += *(const LAS f32x4*)(lds + ((((w * 2 + 1) * 8 + i) * 64 + lp) * 16)); }
            const int row = 16 * i + (lp & 15), cq = 4 * (lp >> 4);
            if constexpr (PAIR) f.pair4(MP + row, (j >> 3) * 128 + (j & 7) * 16 + cq, v0, v1);
            else { pg8::Unit u{0, 0, 0}; f.apply4(u, MP + row, c0 + cq, v0); f.apply4(u, MP + row, c1 + cq, v1); }
        }
    }
    __syncthreads();
}


#define MFMA32(a, b, c) __builtin_amdgcn_mfma_f32_32x32x16_bf16((a), (b), (c), 0, 0, 0)
constexpr int TS = 272;
DI int pi32(int r) { return (r & ~12) | ((r & 4) << 1) | ((r & 8) >> 1); }
DI int keyloc(int i, int hh) { return 16 * (i >> 3) + 8 * hh + (i & 7); }
DI bf16x8 frag_tr(LAS const unsigned char* img, int st, int k0, int m0, int lane) {
    const int hh = lane >> 5, blk = (lane >> 4) & 1, i16 = lane & 15, q = i16 >> 2, p = i16 & 3;
    LAS const unsigned char* a = img + (k0 + 8 * hh + q) * st + (m0 + 16 * blk) * 2 + 8 * p;
    const s16x4 lo = __builtin_amdgcn_ds_read_tr16_b64_v4i16((LAS s16x4*)a), hi = __builtin_amdgcn_ds_read_tr16_b64_v4i16((LAS s16x4*)(a + 4 * st));
    return __builtin_shufflevector(lo, hi, 0, 1, 2, 3, 4, 5, 6, 7);
}
DI bf16x8 frag_row(LAS const unsigned char* img, int st, int row, int k0, int hh) { return *(const LAS bf16x8*)(img + row * st + (k0 + 8 * hh) * 2); }
DI bf16x8 pack8(const f32x16& x, int s) {
    u32x4 p; p[0] = pk2(x[8 * s + 0], x[8 * s + 1]); p[1] = pk2(x[8 * s + 2], x[8 * s + 3]); p[2] = pk2(x[8 * s + 4], x[8 * s + 5]); p[3] = pk2(x[8 * s + 6], x[8 * s + 7]);
    return __builtin_bit_cast(bf16x8, p);
}
DI f32x16 zero16() { f32x16 z;
#pragma unroll
    for (int i = 0; i < 16; ++i) z[i] = 0.f; return z; }
DI void block_scan(LAS float* a, int n, LAS float* tmp, int tid) {
    const int lane = tid & 63, wid = tid >> 6;
    f32x4 v = (f32x4){0.f, 0.f, 0.f, 0.f};
    if (tid * 4 < n) v = *(LAS f32x4*)(a + tid * 4);
    v[1] += v[0]; v[2] += v[1]; v[3] += v[2];
    float s = v[3];
#pragma unroll
    for (int o = 1; o < 64; o <<= 1) { const float t = __shfl_up(s, o); if (lane >= o) s += t; }
    if (lane == 63) tmp[wid] = s;
    __syncthreads();
    float off = s - v[3];
    for (int w = 0; w < wid; ++w) off += tmp[w];
    if (tid * 4 < n) *(LAS f32x4*)(a + tid * 4) = v + off;
    __syncthreads();
}

template <bool SB>
DI void attn_prompt_unit(LAS unsigned char* lds, const bf16* q, const bf16* k, const bf16* v, bf16* out, int b, int hcol, int ocol, int qb, LAS const float* negc, const int wv_) {
    const int tid = wv_ * 64 + lane_id_();
    const int lane = tid & 63, wid = __builtin_amdgcn_readfirstlane(tid >> 6), r = lane & 31, hh = lane >> 5;
    LAS unsigned char* Kt = lds + 16384;
    LAS unsigned char* Vt = Kt + 2 * 64 * TS;
    const int q0 = 256 * qb + 32 * wid;
    const size_t rowb = (size_t)b * SEQ;
    bf16x8 Qf[8];
#pragma unroll
    for (int ks = 0; ks < 8; ++ks) Qf[ks] = *(const bf16x8*)(q + (rowb + q0 + r) * DM + hcol + 16 * ks + 8 * hh);
    f32x16 O[4];
#pragma unroll
    for (int d = 0; d < 4; ++d) O[d] = zero16();
    float m = -INFINITY, l = 0.f, carry = 0.f;
    const int ktmax = 4 * qb + 3, ntile = ktmax + 1;
    const int lrow = tid >> 3, lch = (tid & 7) * 2;
    u32x4 kr[2], vr[2];
    auto gload = [&](int kt) {
        const size_t base = (rowb + 64 * kt + lrow) * DM + hcol + lch * 8;
        kr[0] = *(const u32x4*)(k + base); kr[1] = *(const u32x4*)(k + base + 8); vr[0] = *(const u32x4*)(v + base); vr[1] = *(const u32x4*)(v + base + 8); };
    auto lstore = [&](int buf) {
        LAS unsigned char* kp = Kt + buf * 64 * TS + lrow * TS + lch * 16; LAS unsigned char* vp = Vt + buf * 64 * TS + lrow * TS + lch * 16;
        *(LAS u32x4*)kp = kr[0]; *(LAS u32x4*)(kp + 16) = kr[1]; *(LAS u32x4*)vp = vr[0]; *(LAS u32x4*)(vp + 16) = vr[1]; };
    auto tile_of = [&](int it) { return SB ? (ktmax - it) : it; };
    __syncthreads();
    gload(tile_of(0)); lstore(0);
    __syncthreads();
    for (int it = 0; it < ntile; ++it) {
        const int kt = tile_of(it), buf = it & 1;
        if (it + 1 < ntile) gload(tile_of(it + 1));
        const int key0 = 64 * kt;
        const bool relevant = SB ? (key0 < q0 + 31) : (key0 <= q0 + 31);
        if (relevant) {
            const bool full = SB ? (key0 + 63 < q0) : (key0 + 63 <= q0);
            LAS const unsigned char* Kb = Kt + buf * 64 * TS; LAS const unsigned char* Vb = Vt + buf * 64 * TS;
            f32x16 S[2];
#pragma unroll
            for (int blk = 0; blk < 2; ++blk) {
                if (!SB) {
#pragma unroll
                    for (int g = 0; g < 2; ++g) { const f32x4 c0 = *(const LAS f32x4*)(negc + key0 + 32 * blk + 16 * g + 8 * hh), c1 = *(const LAS f32x4*)(negc + key0 + 32 * blk + 16 * g + 8 * hh + 4);
                        S[blk][8 * g + 0] = c0[0]; S[blk][8 * g + 1] = c0[1]; S[blk][8 * g + 2] = c0[2]; S[blk][8 * g + 3] = c0[3]; S[blk][8 * g + 4] = c1[0]; S[blk][8 * g + 5] = c1[1]; S[blk][8 * g + 6] = c1[2]; S[blk][8 * g + 7] = c1[3]; }
                } else S[blk] = zero16();
#pragma unroll
                for (int ks = 0; ks < 8; ++ks) S[blk] = MFMA32(frag_row(Kb, TS, 32 * blk + pi32(r), 16 * ks, hh), Qf[ks], S[blk]);
            }
            const int qq = q0 + r;
            if (!SB) {
                if (!full) {
#pragma unroll
                    for (int blk = 0; blk < 2; ++blk)
#pragma unroll
                        for (int i = 0; i < 16; ++i) if (key0 + 32 * blk + keyloc(i, hh) > qq) S[blk][i] = -INFINITY;
                }
                float mx = S[0][0];
#pragma unroll
                for (int blk = 0; blk < 2; ++blk)
#pragma unroll
                    for (int i = 0; i < 16; ++i) mx = fmaxf(mx, S[blk][i]);
                mx = fmaxf(mx, __shfl_xor(mx, 32));
                const float mn = fmaxf(m, mx), corr = fexp2(m - mn);
                float ps = 0.f;
#pragma unroll
                for (int blk = 0; blk < 2; ++blk)
#pragma unroll
                    for (int i = 0; i < 16; ++i) { S[blk][i] = fexp2(S[blk][i] - mn); ps += S[blk][i]; }
                l = l * corr + ps; m = mn;
#pragma unroll
                for (int d = 0; d < 4; ++d) O[d] = O[d] * corr;
            } else {
                f32x16 L[2]; float G[4], Go[4];
#pragma unroll
                for (int blk = 0; blk < 2; ++blk)
#pragma unroll
                    for (int g = 0; g < 2; ++g) { float gs = 0.f;
#pragma unroll
                        for (int j = 0; j < 8; ++j) { const int i = 8 * g + j; const float z = S[blk][i];
                            const bool ok = full || (key0 + 32 * blk + keyloc(i, hh) < qq);
                            const float lsm = ok ? -(fmaxf(z, 0.f) + flog2(1.0f + fexp2(-fabsf(z)))) : 0.f;
                            L[blk][i] = lsm; S[blk][i] = ok ? z : -INFINITY; gs += lsm; }
                        G[2 * blk + g] = gs; }
#pragma unroll
                for (int u = 0; u < 4; ++u) Go[u] = __shfl_xor(G[u], 32);
                float above = carry;
#pragma unroll
                for (int u = 3; u >= 0; --u) {
                    float run = above + (hh == 0 ? Go[u] : 0.f);
                    const int blk = u >> 1, g = u & 1;
#pragma unroll
                    for (int j = 7; j >= 0; --j) { const int i = 8 * g + j; run += L[blk][i]; S[blk][i] = fexp2(S[blk][i] + run); }
                    above += G[u] + Go[u];
                }
                carry = above;
            }
#pragma unroll
            for (int ks = 0; ks < 4; ++ks) { const bf16x8 pf = pack8(S[ks >> 1], ks & 1);
#pragma unroll
                for (int d = 0; d < 4; ++d) O[d] = MFMA32(frag_tr(Vb, TS, 16 * ks, 32 * d, lane), pf, O[d]); }
        }
        if (it + 1 < ntile) lstore((it + 1) & 1);
        __syncthreads();
    }
    float inv = 1.0f;
    if (!SB) { const float lt = l + __shfl_xor(l, 32); inv = 1.0f / lt; }
    bf16* op = out + (rowb + q0 + r) * DM + ocol;
#pragma unroll
    for (int d = 0; d < 4; ++d)
#pragma unroll
        for (int g = 0; g < 4; ++g) { u32x2 w; w.x = pk2(O[d][4 * g + 0] * inv, O[d][4 * g + 1] * inv); w.y = pk2(O[d][4 * g + 2] * inv, O[d][4 * g + 3] * inv);
            *(u32x2*)(op + 32 * d + 8 * g + 4 * hh) = w; }
}


DI void hgrn_scan16(const float* lfb, size_t row0, int hc, LAS float* tot, int tid, float (&lf)[16], float (&bl)[16], float& blast, float& bref) {
    const int ch = tid & 127, tq = tid >> 7;
    float run = 0.f;
#pragma unroll
    for (int j = 0; j < 16; ++j) { lf[j] = lfb[(row0 + 16 * tq + j) * W_B + hc + ch]; run += lf[j]; bl[j] = run; }
    __syncthreads();
    tot[tq * 128 + ch] = run;
    __syncthreads();
    const float t0 = tot[ch], t1 = tot[128 + ch], t2 = tot[256 + ch], t3 = tot[384 + ch];
    const float base = (tq > 0 ? t0 : 0.f) + (tq > 1 ? t1 : 0.f) + (tq > 2 ? t2 : 0.f);
#pragma unroll
    for (int j = 0; j < 16; ++j) bl[j] += base;
    blast = (t0 + t1) + (t2 + t3); bref = t0 + t1;
}
DI void copy_tile_bf16(LAS unsigned char* dst, const bf16* src, size_t ld, int rows, int tid) {
    for (int c = tid; c < rows * 16; c += NTHREADS) { const int rr = c >> 4, ch = c & 15; *(LAS u32x4*)(dst + rr * TS + ch * 16) = *(const u32x4*)(src + (size_t)rr * ld + ch * 8); }
}
DI void hgrn_local_unit(LAS unsigned char* lds, const float* lfb, const bf16* ibb, float* dS, float* Dc, int unit, const int wv_) {
    const int tid = wv_ * 64 + lane_id_();
    const int lane = tid & 63, wid = __builtin_amdgcn_readfirstlane(tid >> 6), r = lane & 31, hh = lane >> 5;
    const int bh = unit >> 5, c = unit & 31, b = bh >> 3, h = bh & 7, hc = h * 128;
    const size_t row0 = (size_t)b * SEQ + 64 * c;
    LAS unsigned char* KI = lds; LAS unsigned char* IB = lds + 64 * TS; LAS float* tot = (LAS float*)(lds + 2 * 64 * TS);
    float lf[16], bl[16], blast, bref;
    hgrn_scan16(lfb, row0, hc, tot, tid, lf, bl, blast, bref);
    { const int ch = tid & 127, tq = tid >> 7;
#pragma unroll
      for (int j = 0; j < 16; ++j) { const float kk = (1.0f - __expf(lf[j])) * __expf(blast - bl[j]); *(LAS unsigned short*)(KI + (16 * tq + j) * TS + ch * 2) = (unsigned short)f2bf(kk); }
      if (tq == 0) Dc[(size_t)unit * 128 + ch] = __expf(blast); }
    copy_tile_bf16(IB, ibb + row0 * W_B + hc, W_B, 64, tid);
    __syncthreads();
    const int vblk = wid >> 1, cb0 = (wid & 1) * 2;
    f32x16 acc[2] = {zero16(), zero16()};
#pragma unroll
    for (int ks = 0; ks < 4; ++ks) { const bf16x8 af = frag_tr(IB, TS, 16 * ks, 32 * vblk, lane);
#pragma unroll
        for (int cb = 0; cb < 2; ++cb) acc[cb] = MFMA32(af, frag_tr(KI, TS, 16 * ks, 32 * (cb0 + cb), lane), acc[cb]); }
#pragma unroll
    for (int cb = 0; cb < 2; ++cb)
#pragma unroll
        for (int i = 0; i < 16; ++i) { const int v = 32 * vblk + (i & 3) + 8 * (i >> 2) + 4 * hh; dS[((size_t)unit * 128 + v) * 128 + 32 * (cb0 + cb) + r] = acc[cb][i]; }
    __syncthreads();
}
DI void hgrn_scan_phase(const float* dS, const float* Dc, bf16* Sc, float* hs_out, int G, int tid) {
    for (int gid = blockIdx.x * NTHREADS + tid; gid < 32 * 128 * 32; gid += G * NTHREADS) {
        const int bh = gid >> 12, v = (gid >> 5) & 127, c4 = (gid & 31) * 4;
        f32x4 S = (f32x4){0.f, 0.f, 0.f, 0.f};
#pragma unroll 4
        for (int ck = 0; ck < 32; ++ck) { const size_t unit = (size_t)bh * 32 + ck, idx = (unit * 128 + v) * 128 + c4;
            u32x2 w; w.x = pk2(S[0], S[1]); w.y = pk2(S[2], S[3]); *(u32x2*)(Sc + idx) = w;
            const f32x4 d = *(const f32x4*)(Dc + unit * 128 + c4), x = *(const f32x4*)(dS + idx); S = d * S + x; }
#pragma unroll
        for (int e = 0; e < 4; ++e) hs_out[((size_t)bh * 128 + c4 + e) * 128 + v] = S[e];
    }
}
DI void hgrn_out_unit(LAS unsigned char* lds, const float* lfb, const bf16* qbb, const bf16* ibb, const bf16* gbb, const bf16* Sc, bf16* mrg, int unit, const int wv_) {
    const int tid = wv_ * 64 + lane_id_();
    const int lane = tid & 63, wid = __builtin_amdgcn_readfirstlane(tid >> 6), r = lane & 31, hh = lane >> 5;
    const int bh = unit >> 5, c = unit & 31, b = bh >> 3, h = bh & 7, hc = h * 128;
    const size_t row0 = (size_t)b * SEQ + 64 * c;
    LAS unsigned char* QF = lds; LAS unsigned char* QM = lds + 64 * TS; LAS unsigned char* KM = lds + 2 * 64 * TS; LAS unsigned char* IB = lds + 3 * 64 * TS; LAS unsigned char* ST = lds + 4 * 64 * TS;
    LAS float* tot = (LAS float*)(lds + 4 * 64 * TS + 128 * TS); LAS float* red = tot + 512;
    float lf[16], bl[16], blast, bref;
    hgrn_scan16(lfb, row0, hc, tot, tid, lf, bl, blast, bref);
    { const int ch = tid & 127, tq = tid >> 7;
#pragma unroll
      for (int j = 0; j < 16; ++j) { const int t = 16 * tq + j; const float qv = bf2f(qbb[(row0 + t) * W_B + hc + ch]);
          *(LAS unsigned short*)(QF + t * TS + ch * 2) = (unsigned short)f2bf(qv * __expf(bl[j]));
          *(LAS unsigned short*)(QM + t * TS + ch * 2) = (unsigned short)f2bf(qv * __expf(bl[j] - bref));
          *(LAS unsigned short*)(KM + t * TS + ch * 2) = (unsigned short)f2bf((1.0f - __expf(lf[j])) * __expf(bref - bl[j])); } }
    copy_tile_bf16(IB, ibb + row0 * W_B + hc, W_B, 64, tid);
    copy_tile_bf16(ST, Sc + (size_t)unit * 128 * 128, 128, 128, tid);
    __syncthreads();
    const int vblk = wid & 3, tblk = wid >> 2;
    f32x16 SA[2] = {zero16(), zero16()};
#pragma unroll
    for (int sb = 0; sb < 2; ++sb)
#pragma unroll
        for (int ks = 0; ks < 8; ++ks) SA[sb] = MFMA32(frag_row(KM, TS, 32 * sb + pi32(r), 16 * ks, hh), frag_row(QM, TS, 32 * tblk + r, 16 * ks, hh), SA[sb]);
    const int tt = 32 * tblk + r;
#pragma unroll
    for (int sb = 0; sb < 2; ++sb)
#pragma unroll
        for (int i = 0; i < 16; ++i) if (32 * sb + keyloc(i, hh) > tt) SA[sb][i] = 0.f;
    f32x16 O = zero16();
#pragma unroll
    for (int ks = 0; ks < 4; ++ks) O = MFMA32(frag_tr(IB, TS, 16 * ks, 32 * vblk, lane), pack8(SA[ks >> 1], ks & 1), O);
#pragma unroll
    for (int ks = 0; ks < 8; ++ks) O = MFMA32(frag_row(ST, TS, 32 * vblk + r, 16 * ks, hh), frag_row(QF, TS, 32 * tblk + r, 16 * ks, hh), O);
    float ss = 0.f;
#pragma unroll
    for (int i = 0; i < 16; ++i) ss += O[i] * O[i];
    ss += __shfl_xor(ss, 32);
    if (hh == 0) red[vblk * 64 + tt] = ss;
    __syncthreads();
    const float rstd = 1.0f / sqrtf(((red[tt] + red[64 + tt]) + (red[128 + tt] + red[192 + tt])) * (1.0f / 128.0f) + RMS_EPS);
#pragma unroll
    for (int g = 0; g < 4; ++g) { const int v = 32 * vblk + 8 * g + 4 * hh;
        const u32x2 gw = *(const u32x2*)(gbb + (row0 + tt) * W_B + hc + v);
        const float g0 = bf2f((unsigned short)(gw.x & 0xffff)), g1 = bf2f((unsigned short)(gw.x >> 16)), g2 = bf2f((unsigned short)(gw.y & 0xffff)), g3 = bf2f((unsigned short)(gw.y >> 16));
        u32x2 w; w.x = pk2(O[4 * g + 0] * rstd * g0, O[4 * g + 1] * rstd * g1); w.y = pk2(O[4 * g + 2] * rstd * g2, O[4 * g + 3] * rstd * g3);
        *(u32x2*)(mrg + (row0 + tt) * DM + W_A + hc + v) = w; }
    __syncthreads();
}
DI void hgrn_sample_unit(LAS unsigned char* lds, const float* lfb, const bf16* qbb, const bf16* ibb, const bf16* gbb, const float* s0, float* hs_out, bf16* mrg, int unit, const int wv_) {
    const int tid = wv_ * 64 + lane_id_();
    const int b = unit >> 3, h = unit & 7, hc = h * 128;
    const size_t row0 = (size_t)MP + b * 16;
    LAS float* fl = (LAS float*)lds; LAS float* ql = fl + 2048; LAS float* il = ql + 2048; LAS float* part = il + 2048;
    __syncthreads();
    for (int e = tid; e < 2048; e += NTHREADS) { const int t = e >> 7, c = e & 127; const size_t g = (row0 + t) * W_B + hc + c;
        fl[e] = __expf(lfb[g]); ql[e] = bf2f(qbb[g]); il[e] = bf2f(ibb[g]); }
    __syncthreads();
    const int v = tid & 127, cq = tid >> 7;
    float S[32];
#pragma unroll
    for (int j = 0; j < 32; ++j) S[j] = s0[((size_t)unit * 128 + 32 * cq + j) * 128 + v];
#pragma unroll 1
    for (int t = 0; t < 16; ++t) { const float iv = il[t * 128 + v]; float o = 0.f;
#pragma unroll
        for (int j = 0; j < 32; ++j) { const float f = fl[t * 128 + 32 * cq + j]; S[j] = f * S[j] + (1.0f - f) * iv; o += S[j] * ql[t * 128 + 32 * cq + j]; }
        part[(cq * 16 + t) * 128 + v] = o; }
#pragma unroll
    for (int j = 0; j < 32; ++j) hs_out[((size_t)unit * 128 + 32 * cq + j) * 128 + v] = S[j];
    __syncthreads();
    { const int t = tid >> 5, v4 = (tid & 31) * 4; f32x4 o = (f32x4){0.f, 0.f, 0.f, 0.f};
#pragma unroll
      for (int q4 = 0; q4 < 4; ++q4) o += *(const LAS f32x4*)(part + (q4 * 16 + t) * 128 + v4);
      float ss = (o[0] * o[0] + o[1] * o[1]) + (o[2] * o[2] + o[3] * o[3]);
#pragma unroll
      for (int of = 1; of < 32; of <<= 1) ss += __shfl_xor(ss, of);
      const float rstd = 1.0f / sqrtf(ss * (1.0f / 128.0f) + RMS_EPS);
      const size_t g = (row0 + t) * W_B + hc + v4;
      u32x2 w; w.x = pk2(o[0] * rstd * bf2f(gbb[g]), o[1] * rstd * bf2f(gbb[g + 1])); w.y = pk2(o[2] * rstd * bf2f(gbb[g + 2]), o[3] * rstd * bf2f(gbb[g + 3]));
      *(u32x2*)(mrg + (row0 + t) * DM + W_A + hc + v4) = w; }
    __syncthreads();
}


template <bool SB>
DI void attn_sample_unit(LAS unsigned char* lds, const bf16* q, const float* ck, const float* cv, const float* nk, const float* nv, const float* clf, const float* nlf,
                         bf16* out, int b, int h, int H, const int wv_) {
    const int tid = wv_ * 64 + lane_id_();
    const int lane = tid & 63, wid = __builtin_amdgcn_readfirstlane(tid >> 6), r = lane & 31, hh = lane >> 5, t = r & 15;
    const int hcol = h * 128; const size_t stride = (size_t)H * 128;
    LAS float* negc = (LAS float*)lds; LAS float* tmp = negc + 1056; LAS float* Ow = (LAS float*)(lds + 8192); LAS float* mlw = (LAS float*)(lds + 8192 + 65536);
    __syncthreads();
    if (!SB) {
        for (int e = tid; e < 1056; e += NTHREADS) negc[e] = e < 1024 ? clf[((size_t)b * 1024 + e) * H + h] : (e < 1040 ? nlf[((size_t)b * 16 + e - 1024) * H + h] : 0.f);
        __syncthreads();
        block_scan(negc, 1056, tmp, tid);
        for (int e = tid; e < 1056; e += NTHREADS) negc[e] = -negc[e] * LOG2E;
        __syncthreads();
    }
    const size_t qrow = (size_t)MP + b * 16 + t;
    bf16x8 Qf[8];
#pragma unroll
    for (int ks = 0; ks < 8; ++ks) Qf[ks] = *(const bf16x8*)(q + qrow * DM + hcol + 16 * ks + 8 * hh);
    const int blo = (wid * 33) >> 3, bhi = ((wid + 1) * 33) >> 3;
    auto kbase = [&](const float* c, const float* n, int blk) { return blk < 32 ? c + (((size_t)b * 1024 + 32 * blk) * H + h) * 128 : n + (((size_t)b * 16) * H + h) * 128; };
    auto scores = [&](int blk, f32x16& S) {
        const float* kb_ = kbase(ck, nk, blk); const int kmax = blk < 32 ? 31 : 15;
        const int kl = pi32(r); const float* kp = kb_ + (size_t)(kl < kmax ? kl : kmax) * stride + 8 * hh;
#pragma unroll
        for (int ks = 0; ks < 8; ++ks) { const f32x4 a = *(const f32x4*)(kp + 16 * ks), c = *(const f32x4*)(kp + 16 * ks + 4);
            u32x4 p; p[0] = pk2(a[0], a[1]); p[1] = pk2(a[2], a[3]); p[2] = pk2(c[0], c[1]); p[3] = pk2(c[2], c[3]);
            S = MFMA32(__builtin_bit_cast(bf16x8, p), Qf[ks], S); } };
    auto pv = [&](int blk, const f32x16& P, f32x16 (&O)[4]) {
        const float* vb_ = kbase(cv, nv, blk); const int kmax = blk < 32 ? 31 : 15;
#pragma unroll
        for (int s = 0; s < 2; ++s) { const bf16x8 pf = pack8(P, s);
#pragma unroll
            for (int d = 0; d < 4; ++d) { float x[8];
#pragma unroll
                for (int j = 0; j < 8; ++j) { const int kl = 16 * s + 8 * hh + j; x[j] = vb_[(size_t)(kl < kmax ? kl : kmax) * stride + 32 * d + r]; }
                u32x4 p; p[0] = pk2(x[0], x[1]); p[1] = pk2(x[2], x[3]); p[2] = pk2(x[4], x[5]); p[3] = pk2(x[6], x[7]);
                O[d] = MFMA32(__builtin_bit_cast(bf16x8, p), pf, O[d]); } } };
    f32x16 O[4] = {zero16(), zero16(), zero16(), zero16()};
    if (!SB) {
        float m = -INFINITY, l = 0.f;
        for (int blk = blo; blk < bhi; ++blk) {
            f32x16 S;
#pragma unroll
            for (int g = 0; g < 2; ++g) { const f32x4 c0 = *(const LAS f32x4*)(negc + 32 * blk + 16 * g + 8 * hh), c1 = *(const LAS f32x4*)(negc + 32 * blk + 16 * g + 8 * hh + 4);
                S[8 * g + 0] = c0[0]; S[8 * g + 1] = c0[1]; S[8 * g + 2] = c0[2]; S[8 * g + 3] = c0[3]; S[8 * g + 4] = c1[0]; S[8 * g + 5] = c1[1]; S[8 * g + 6] = c1[2]; S[8 * g + 7] = c1[3]; }
            scores(blk, S);
            float mx = -INFINITY;
#pragma unroll
            for (int i = 0; i < 16; ++i) { const int key = 32 * blk + keyloc(i, hh); if (key > 1024 + t) S[i] = -INFINITY; mx = fmaxf(mx, S[i]); }
            mx = fmaxf(mx, __shfl_xor(mx, 32));
            const float mn = fmaxf(m, mx), corr = fexp2(m - mn); float ps = 0.f;
#pragma unroll
            for (int i = 0; i < 16; ++i) { S[i] = fexp2(S[i] - mn); ps += S[i]; }
            l = l * corr + ps; m = mn;
#pragma unroll
            for (int d = 0; d < 4; ++d) O[d] = O[d] * corr;
            pv(blk, S, O);
        }
        l += __shfl_xor(l, 32);
        if (lane < 16) { mlw[wid * 16 + lane] = m; mlw[128 + wid * 16 + lane] = l; }
    } else {
        float tot = 0.f;
        for (int blk = blo; blk < bhi; ++blk) { f32x16 S = zero16(); scores(blk, S);
#pragma unroll
            for (int i = 0; i < 16; ++i) { const int key = 32 * blk + keyloc(i, hh); const float z = S[i]; if (key < 1024 + t) tot += -(fmaxf(z, 0.f) + flog2(1.0f + fexp2(-fabsf(z)))); } }
        tot += __shfl_xor(tot, 32);
        if (lane < 16) mlw[256 + wid * 16 + lane] = tot;
        __syncthreads();
        float carry = 0.f;
        for (int w = wid + 1; w < 8; ++w) carry += mlw[256 + w * 16 + t];
        for (int blk = bhi - 1; blk >= blo; --blk) { f32x16 S = zero16(), L; scores(blk, S);
            float G[2], Go[2];
#pragma unroll
            for (int g = 0; g < 2; ++g) { float gs = 0.f;
#pragma unroll
                for (int j = 0; j < 8; ++j) { const int i = 8 * g + j; const float z = S[i]; const bool ok = (32 * blk + keyloc(i, hh)) < 1024 + t;
                    const float lsm = ok ? -(fmaxf(z, 0.f) + flog2(1.0f + fexp2(-fabsf(z)))) : 0.f; L[i] = lsm; S[i] = ok ? z : -INFINITY; gs += lsm; }
                G[g] = gs; }
            Go[0] = __shfl_xor(G[0], 32); Go[1] = __shfl_xor(G[1], 32);
            float above = carry;
#pragma unroll
            for (int u = 1; u >= 0; --u) { float run = above + (hh == 0 ? Go[u] : 0.f);
#pragma unroll
                for (int j = 7; j >= 0; --j) { const int i = 8 * u + j; run += L[i]; S[i] = fexp2(S[i] + run); }
                above += G[u] + Go[u]; }
            carry = above;
            pv(blk, S, O);
        }
    }
    if (r < 16) {
#pragma unroll
        for (int d = 0; d < 4; ++d)
#pragma unroll
            for (int i = 0; i < 16; ++i) Ow[(wid * 128 + 32 * d + (i & 3) + 8 * (i >> 2) + 4 * hh) * 16 + r] = O[d][i];
    }
    __syncthreads();
    { const int tq = tid >> 5, d4 = (tid & 31) * 4; float sc[8]; float Lt = 1.0f;
      if (!SB) { float M = -INFINITY;
#pragma unroll
          for (int w = 0; w < 8; ++w) M = fmaxf(M, mlw[w * 16 + tq]);
          Lt = 0.f;
#pragma unroll
          for (int w = 0; w < 8; ++w) { sc[w] = fexp2(mlw[w * 16 + tq] - M); Lt += mlw[128 + w * 16 + tq] * sc[w]; }
          Lt = 1.0f / Lt; }
      else {
#pragma unroll
          for (int w = 0; w < 8; ++w) sc[w] = 1.0f; }
      float o[4] = {0.f, 0.f, 0.f, 0.f};
#pragma unroll
      for (int w = 0; w < 8; ++w)
#pragma unroll
          for (int e = 0; e < 4; ++e) o[e] += Ow[(w * 128 + d4 + e) * 16 + tq] * sc[w];
      u32x2 wv; wv.x = pk2(o[0] * Lt, o[1] * Lt); wv.y = pk2(o[2] * Lt, o[3] * Lt);
      *(u32x2*)(out + ((size_t)MP + b * 16 + tq) * DM + hcol + d4) = wv; }
    __syncthreads();
}

struct FMemKV { float* ok; float* ov; bf16* kb;
    DI void apply4(const pg8::Unit&, int row, int col, f32x4 v) const {
        if (col < DM) { *(f32x4*)(ok + (size_t)row * DM + col) = v; u32x2 w; w.x = pk2(v[0], v[1]); w.y = pk2(v[2], v[3]); *(u32x2*)(kb + (size_t)row * DM + col) = w; }
        else { *(f32x4*)(ov + (size_t)row * DM + (col - DM)) = v; }
    } };
struct FBf16 { bf16* o; int ld; float sc;
    DI void apply4(const pg8::Unit&, int row, int col, f32x4 v) const { u32x2 w; w.x = pk2(v[0] * sc, v[1] * sc); w.y = pk2(v[2] * sc, v[3] * sc); *(u32x2*)(o + (size_t)row * ld + col) = w; } };


struct FSwiglu { bf16* h;
    DI void pair4(int row, int hc, f32x4 g, f32x4 u) const { u32x2 w; w.x = pk2(siluf_(g[0]) * u[0], siluf_(g[1]) * u[1]); w.y = pk2(siluf_(g[2]) * u[2], siluf_(g[3]) * u[3]);
        *(u32x2*)(h + (size_t)row * D_FF + hc) = w; } };
struct FResid { float* x32; float sc;
    DI void apply4(const pg8::Unit&, int row, int col, f32x4 v) const { float* p = x32 + (size_t)row * DM + col; const f32x4 r = *(const f32x4*)p; *(f32x4*)p = r * ALPHA + v * sc; } };
constexpr float QS128 = 0.08838834764831845f * LOG2E;
constexpr float QS512 = 0.04419417382415922f * LOG2E;
struct FEvenIn { float* out; unsigned char* ws; const float *b_f, *lbl, *ng;
    DI void apply4(const pg8::Unit&, int row, int col, f32x4 v) const {
        const int seg = col >> 10, c = col & 1023; const bool smp = row >= MP;
        if (seg == 0) { u32x2 w; w.x = pk2(v[0] * QS128, v[1] * QS128); w.y = pk2(v[2] * QS128, v[3] * QS128); *(u32x2*)((bf16*)(ws + WS_Q) + (size_t)row * DM + c) = w; }
        else if (seg == 1 || seg == 2) {
            const size_t oo = smp ? (seg == 1 ? O_FKS : O_FVS) + (size_t)(row - MP) * W_A + c : (seg == 1 ? O_FK : O_FV) + (size_t)row * W_A + c;
            *(f32x4*)(out + oo) = v;
            if (!smp) { u32x2 w; w.x = pk2(v[0], v[1]); w.y = pk2(v[2], v[3]); *(u32x2*)((bf16*)(ws + (seg == 1 ? WS_KB : WS_VB)) + (size_t)row * DM + c) = w; }
        } else if (seg == 3) { u32x2 w; w.x = pk2(siluf_(v[0]), siluf_(v[1])); w.y = pk2(siluf_(v[2]), siluf_(v[3])); *(u32x2*)((bf16*)(ws + WS_QBB) + (size_t)row * W_B + c) = w; }
        else if (seg == 4) { const f32x4 l0 = *(const f32x4*)(lbl + c), l1 = *(const f32x4*)(lbl + W_B + c); f32x4 r;
#pragma unroll
            for (int e = 0; e < 4; ++e) { const float lb = 1.0f / (1.0f + __expf(l1[e] - l0[e])); r[e] = __logf(lb + (1.0f - lb) * sigmoidf_(v[e])); }
            *(f32x4*)((float*)(ws + WS_LFB) + (size_t)row * W_B + c) = r; }
        else if (seg == 5) { u32x2 w; w.x = pk2(v[0], v[1]); w.y = pk2(v[2], v[3]); *(u32x2*)((bf16*)(ws + WS_IBB) + (size_t)row * W_B + c) = w; }
        else if (seg == 6) { const f32x4 g = *(const f32x4*)(ng + c); u32x2 w; w.x = pk2(g[0] * siluf_(v[0]), g[1] * siluf_(v[1])); w.y = pk2(g[2] * siluf_(v[2]), g[3] * siluf_(v[3])); *(u32x2*)((bf16*)(ws + WS_GBB) + (size_t)row * W_B + c) = w; }
        else if (c < 8) { const f32x4 b = *(const f32x4*)(b_f + c); f32x4 r;
#pragma unroll
            for (int e = 0; e < 4; ++e) r[e] = logsigmoidf_(v[e] + b[e]);
            const size_t oo = smp ? O_FLFS + (size_t)(row - MP) * H_A + c : O_FLF + (size_t)row * H_A + c;
            *(f32x4*)(out + oo) = r; }
    } };
struct FOddIn { float* out; unsigned char* ws;
    DI void apply4(const pg8::Unit&, int row, int col, f32x4 v) const {
        const int seg = col >> 11, c = col & 2047; const bool smp = row >= MP;
        if (seg == 0) { u32x2 w; w.x = pk2(v[0] * QS128, v[1] * QS128); w.y = pk2(v[2] * QS128, v[3] * QS128); *(u32x2*)((bf16*)(ws + WS_Q) + (size_t)row * DM + c) = w; }
        else { const size_t oo = smp ? (seg == 1 ? O_SKS : O_SVS) + (size_t)(row - MP) * W_C + c : (seg == 1 ? O_SK : O_SV) + (size_t)row * W_C + c;
            *(f32x4*)(out + oo) = v;
            if (!smp) { u32x2 w; w.x = pk2(v[0], v[1]); w.y = pk2(v[2], v[3]); *(u32x2*)((bf16*)(ws + (seg == 1 ? WS_KB : WS_VB)) + (size_t)row * DM + c) = w; } }
    } };
struct CrossSOrder { const bf16* Q; const bf16* Kmem; int lda, ldb, G, c;
    DI bool next(int i, pg8::Unit& u) const { const int L = i * G + c; if (L >= 128) return false; u.z = L >> 3; u.pm = L & 7; u.pn = 0; return true; }
    DI const char* pa(const pg8::Unit& u) const { return (const char*)(Q + ((size_t)(u.z >> 2) * SEQ + 256 * u.pm) * DM + (u.z & 3) * HD_X); }
    DI const char* pb(const pg8::Unit& u) const { return (const char*)(Kmem + ((size_t)(u.z >> 2) * N_MEM) * DM + (u.z & 3) * HD_X); } };
struct CrossOOrder { const bf16* P; const bf16* VT; int lda, ldb, G, c;
    DI bool next(int i, pg8::Unit& u) const { const int L = i * G + c; if (L >= 256) return false; u.z = L >> 4; u.pm = (L >> 1) & 7; u.pn = L & 1; return true; }
    DI const char* pa(const pg8::Unit& u) const { return (const char*)(P + ((size_t)(u.z >> 2) * SEQ + 256 * u.pm) * 1024 + (u.z & 3) * N_MEM); }
    DI const char* pb(const pg8::Unit& u) const { return (const char*)(VT + ((size_t)(u.z & 3) * HD_X + 256 * u.pn) * 1024 + (u.z >> 2) * N_MEM); } };
struct FCrossO { bf16* o;
    DI void apply4(const pg8::Unit& u, int row, int col, f32x4 v) const { u32x2 w; w.x = pk2(v[0], v[1]); w.y = pk2(v[2], v[3]);
        *(u32x2*)(o + ((size_t)(u.z >> 2) * SEQ + row) * DM + (u.z & 3) * HD_X + col) = w; } };
struct EpiSoftmax {
    static constexpr bool AFTER_DRAIN = true;
    bf16* P;
    DI void fused(f32x4 (&acc)[2][2][4][2], const pg8::Unit& u, int wr, int wc, int fr, int fq, LAS unsigned char* lds, int wid, int lane) const {
        LAS float* MX = (LAS float*)lds; LAS float* SM = MX + 1024;
        float rm[2][4];
#pragma unroll
        for (int ai = 0; ai < 2; ++ai)
#pragma unroll
            for (int m = 0; m < 4; ++m) { float mx = -INFINITY;
#pragma unroll
                for (int bj = 0; bj < 2; ++bj)
#pragma unroll
                    for (int n = 0; n < 2; ++n) { const f32x4 x = acc[ai][bj][m][n]; mx = fmaxf(mx, fmaxf(fmaxf(x[0], x[1]), fmaxf(x[2], x[3]))); }
                mx = fmaxf(mx, __shfl_xor(mx, 16)); mx = fmaxf(mx, __shfl_xor(mx, 32));
                if (fq == 0) MX[(ai * 128 + wr * 64 + m * 16 + fr) * 4 + wc] = mx; }
        __syncthreads();
#pragma unroll
        for (int ai = 0; ai < 2; ++ai)
#pragma unroll
            for (int m = 0; m < 4; ++m) { const f32x4 q4 = *(const LAS f32x4*)(MX + (ai * 128 + wr * 64 + m * 16 + fr) * 4); const float M = fmaxf(fmaxf(q4[0], q4[1]), fmaxf(q4[2], q4[3])); float s = 0.f;
#pragma unroll
                for (int bj = 0; bj < 2; ++bj)
#pragma unroll
                    for (int n = 0; n < 2; ++n) { f32x4 x = acc[ai][bj][m][n]; x[0] = fexp2(x[0] - M); x[1] = fexp2(x[1] - M); x[2] = fexp2(x[2] - M); x[3] = fexp2(x[3] - M); acc[ai][bj][m][n] = x; s += (x[0] + x[1]) + (x[2] + x[3]); }
                s += __shfl_xor(s, 16); s += __shfl_xor(s, 32);
                if (fq == 0) SM[(ai * 128 + wr * 64 + m * 16 + fr) * 4 + wc] = s; rm[ai][m] = 0.f; }
        __syncthreads();
#pragma unroll
        for (int ai = 0; ai < 2; ++ai)
#pragma unroll
            for (int m = 0; m < 4; ++m) { const int rl = ai * 128 + wr * 64 + m * 16 + fr; const f32x4 q4 = *(const LAS f32x4*)(SM + rl * 4); const float inv = 1.0f / ((q4[0] + q4[1]) + (q4[2] + q4[3]));
                bf16* pr = P + ((size_t)(u.z >> 2) * SEQ + 256 * u.pm + rl) * 1024 + (u.z & 3) * N_MEM;
#pragma unroll
                for (int bj = 0; bj < 2; ++bj)
#pragma unroll
                    for (int n = 0; n < 2; ++n) { const f32x4 x = acc[ai][bj][m][n] * inv; u32x2 w; w.x = pk2(x[0], x[1]); w.y = pk2(x[2], x[3]); *(u32x2*)(pr + bj * 128 + wc * 32 + n * 16 + 4 * fq) = w; } }
        (void)rm; (void)wid; (void)lane;
    }
};
DI void cross_sample_unit(LAS unsigned char* lds, const bf16* q, const float* mk, const float* mv, bf16* out, int b, int hx, const int wv_) {
    const int tid = wv_ * 64 + lane_id_();
    const int lane = tid & 63, wid = __builtin_amdgcn_readfirstlane(tid >> 6), r = lane & 31, hh = lane >> 5, t = r & 15;
    LAS float* Ow = (LAS float*)(lds + 8192); LAS float* mlw = (LAS float*)lds;
    const float* kp = mk + ((size_t)b * N_MEM + 32 * wid + pi32(r)) * DM + hx * HD_X + 8 * hh;
    const bf16* qp = q + ((size_t)MP + b * 16 + t) * DM + hx * HD_X + 8 * hh;
    __syncthreads();
    f32x16 S = zero16();
#pragma unroll 8
    for (int ks = 0; ks < 32; ++ks) { const f32x4 a = *(const f32x4*)(kp + 16 * ks), c = *(const f32x4*)(kp + 16 * ks + 4);
        u32x4 p; p[0] = pk2(a[0], a[1]); p[1] = pk2(a[2], a[3]); p[2] = pk2(c[0], c[1]); p[3] = pk2(c[2], c[3]);
        S = MFMA32(__builtin_bit_cast(bf16x8, p), *(const bf16x8*)(qp + 16 * ks), S); }
    float mx = S[0];
#pragma unroll
    for (int i = 1; i < 16; ++i) mx = fmaxf(mx, S[i]);
    mx = fmaxf(mx, __shfl_xor(mx, 32));
    if (lane < 16) mlw[wid * 16 + lane] = mx;
    __syncthreads();
    float M = -INFINITY;
#pragma unroll
    for (int w = 0; w < 8; ++w) M = fmaxf(M, mlw[w * 16 + t]);
    float ps = 0.f;
#pragma unroll
    for (int i = 0; i < 16; ++i) { S[i] = fexp2(S[i] - M); ps += S[i]; }
    ps += __shfl_xor(ps, 32);
    if (lane < 16) mlw[128 + wid * 16 + lane] = ps;
    const bf16x8 pf0 = pack8(S, 0), pf1 = pack8(S, 1);
    const float* vp = mv + ((size_t)b * N_MEM + 32 * wid) * DM + hx * HD_X + r;
#pragma unroll 1
    for (int pass = 0; pass < 4; ++pass) {
        f32x16 O[4] = {zero16(), zero16(), zero16(), zero16()};
#pragma unroll
        for (int s = 0; s < 2; ++s)
#pragma unroll
            for (int d = 0; d < 4; ++d) { float x[8];
#pragma unroll
                for (int j = 0; j < 8; ++j) x[j] = vp[(size_t)(16 * s + 8 * hh + j) * DM + 128 * pass + 32 * d];
                u32x4 p; p[0] = pk2(x[0], x[1]); p[1] = pk2(x[2], x[3]); p[2] = pk2(x[4], x[5]); p[3] = pk2(x[6], x[7]);
                O[d] = MFMA32(__builtin_bit_cast(bf16x8, p), s == 0 ? pf0 : pf1, O[d]); }
        __syncthreads();
        if (r < 16) {
#pragma unroll
            for (int d = 0; d < 4; ++d)
#pragma unroll
                for (int i = 0; i < 16; ++i) Ow[(wid * 128 + 32 * d + (i & 3) + 8 * (i >> 2) + 4 * hh) * 16 + r] = O[d][i]; }
        __syncthreads();
        { const int tq = tid >> 5, d4 = (tid & 31) * 4; float Lt = 0.f;
#pragma unroll
          for (int w = 0; w < 8; ++w) Lt += mlw[128 + w * 16 + tq];
          Lt = 1.0f / Lt; float o[4] = {0.f, 0.f, 0.f, 0.f};
#pragma unroll
          for (int w = 0; w < 8; ++w)
#pragma unroll
              for (int e = 0; e < 4; ++e) o[e] += Ow[(w * 128 + d4 + e) * 16 + tq];
          u32x2 wv; wv.x = pk2(o[0] * Lt, o[1] * Lt); wv.y = pk2(o[2] * Lt, o[3] * Lt);
          *(u32x2*)(out + ((size_t)MP + b * 16 + tq) * DM + hx * HD_X + 128 * pass + d4) = wv; }
    }
    __syncthreads();
}

DI void ln_phase(float* x32, bf16* xb, const float* g, const float* b, float* yout, int gw, int NGW, int lane) {
    for (int row = gw; row < MT; row += NGW) {
        float* xr = x32 + (size_t)row * DM;
        f32x4 v[8]; float s = 0.f;
#pragma unroll
        for (int j = 0; j < 8; ++j) { v[j] = *(const f32x4*)(xr + (lane + 64 * j) * 4); s += (v[j][0] + v[j][1]) + (v[j][2] + v[j][3]); }
        const float mean = wave_sum(s) * (1.0f / DM); float s2 = 0.f;
#pragma unroll
        for (int j = 0; j < 8; ++j) { v[j] = v[j] - mean; s2 += (v[j][0] * v[j][0] + v[j][1] * v[j][1]) + (v[j][2] * v[j][2] + v[j][3] * v[j][3]); }
        const float rstd = 1.0f / sqrtf(wave_sum(s2) * (1.0f / DM) + LN_EPS);
#pragma unroll
        for (int j = 0; j < 8; ++j) { const int cc = (lane + 64 * j) * 4; const f32x4 gg = *(const f32x4*)(g + cc), bb = *(const f32x4*)(b + cc);
            const f32x4 y = v[j] * rstd * gg + bb; *(f32x4*)(xr + cc) = y;
            u32x2 w; w.x = pk2(y[0], y[1]); w.y = pk2(y[2], y[3]); *(u32x2*)(xb + (size_t)row * DM + cc) = w;
            if (yout) *(f32x4*)(yout + (size_t)row * DM + cc) = y; }
    }
}

struct Args { const float* in[29]; float* out; unsigned char* ws; int ph_lo, ph_hi; };

template <int MODE>
DI int wmap(int n) {
    if (MODE == 1) return (n >> 7) * 256 + (n & 127);
    if (MODE == 2) return (n >> 7) * 256 + 128 + (n & 127);
    if (MODE == 3) return n < 3072 ? n : (n < 3080 ? 7168 + (n - 3072) : n - 8);
    return n;
}
template <int MODE>
DI void transpose_item(const float* W, int K, int N, bf16* WT, LAS float* scr, int item, int lane) {
    const int nblk = (N + 31) / 32, kb = item / nblk, nb = item % nblk, k0 = 64 * kb, n0 = 32 * nb;
    const int nn = n0 + (lane & 31);
#pragma unroll 8
    for (int i = 0; i < 32; ++i) { const int kk = 2 * i + (lane >> 5); scr[kk * 33 + (lane & 31)] = (nn < N) ? W[(size_t)(k0 + kk) * N + nn] : 0.f; }
    LDS_WAIT(); asm volatile("" ::: "memory");
    const int c = lane & 7;
#pragma unroll
    for (int j = 0; j < 4; ++j) { const int n = (lane >> 3) + 8 * j; const LAS float* s = scr + (8 * c) * 33 + n;
        u32x4 o; o.x = pk2(s[0 * 33], s[1 * 33]); o.y = pk2(s[2 * 33], s[3 * 33]); o.z = pk2(s[4 * 33], s[5 * 33]); o.w = pk2(s[6 * 33], s[7 * 33]);
        if (n0 + n < N) *(u32x4*)(WT + (size_t)wmap<MODE>(n0 + n) * K + k0 + 8 * c) = o; }
    LDS_WAIT(); asm volatile("" ::: "memory");
}

DI bool in_phase_(int lo, int hi, int k) { asm volatile("" : "+s"(lo), "+s"(hi)); return lo <= k && k < hi; }
#define IN(k) in_phase_(lo, hi, (k))
#define SEAM(k) do { if (IN(k) && IN((k) + 1)) xcd_barrier(bar); } while (0)
#define PH_BEGIN const int lane = lane_id_(); const int tid = wave * 64 + lane; (void)tid; GAS unsigned char* ws_g = (GAS unsigned char*)args.ws; asm volatile("" : "+s"(ws_g)); unsigned char* ws = (unsigned char*)ws_g; GAS float* out_g = (GAS float*)args.out; asm volatile("" : "+s"(out_g)); float* outp = (float*)out_g; \
    bf16* Wgu = (bf16*)(ws + WS_WGU); bf16* Wd = (bf16*)(ws + WS_WD); bf16* Wq = (bf16*)(ws + WS_WQ); bf16* Wkv = (bf16*)(ws + WS_WKV); bf16* Wo = (bf16*)(ws + WS_WO); \
    bf16* WinE = (bf16*)(ws + WS_WINE); bf16* WoutE = (bf16*)(ws + WS_WOUTE); bf16* WinO = (bf16*)(ws + WS_WINO); bf16* WoutO = (bf16*)(ws + WS_WOUTO); \
    float* x32 = (float*)(ws + WS_X32); bf16* xb = (bf16*)(ws + WS_XB); \
    bf16* memb = (bf16*)(ws + WS_MEMB); bf16* memK = (bf16*)(ws + WS_MEMK); bf16* memVT = (bf16*)(ws + WS_MEMVT); \
    bf16* hbuf = (bf16*)(ws + WS_H); bf16* mrg = (bf16*)(ws + WS_MRG); bf16* qbuf = (bf16*)(ws + WS_Q); bf16* kbuf = (bf16*)(ws + WS_KB); bf16* vbuf = (bf16*)(ws + WS_VB); \
    bf16* qbb = (bf16*)(ws + WS_QBB); bf16* ibb = (bf16*)(ws + WS_IBB); bf16* gbb = (bf16*)(ws + WS_GBB); float* lfb = (float*)(ws + WS_LFB); \
    (void)Wgu; (void)Wd; (void)Wq; (void)Wkv; (void)Wo; (void)WinE; (void)WoutE; (void)WinO; (void)WoutO; (void)x32; (void)xb; (void)memb; (void)memK; (void)memVT; \
    (void)hbuf; (void)mrg; (void)qbuf; (void)kbuf; (void)vbuf; (void)qbb; (void)ibb; (void)gbb; (void)lfb; (void)outp;
#define INP(k) ({ GAS const float* _p = (GAS const float*)args.in[k]; asm volatile("" : "+s"(_p)); (const float*)_p; })

template <int l>
DI void layer_body(const Args& args, LAS unsigned char* lds, const int wave, const int G, const int lo, const int hi, const XcdBarrier& bar) {
    const int gw = blockIdx.x * NWAVES + wave, NGW = G * NWAVES;
    const int pb = 2 + l * PH_PER_LAYER;
        if (IN(pb + 0)) {
            PH_BEGIN
            const bf16* W = Wgu + (size_t)(2 * l) * NGU * DM;
            { pg8::GridOrder S; S.init(xb, DM, W, DM, 32, 43, G, (int)blockIdx.x); pg8::EpiPair<FSwiglu> E{{hbuf}}; pg8::gemm_phase(lds, S, DM, E, wave); }
            skinny_phase<true>(lds, xb + (size_t)MP * DM, DM, W, DM, DM, 344, FSwiglu{hbuf}, wave);
        }
        SEAM(pb + 0);
        if (IN(pb + 1)) {
            PH_BEGIN
            const bf16* W = Wd + (size_t)(2 * l) * DM * D_FF;
            { pg8::GridOrder S; S.init(hbuf, D_FF, W, D_FF, 32, 8, G, (int)blockIdx.x); pg8::EpiEach<FResid> E{{x32, 0.5f}}; pg8::gemm_phase(lds, S, D_FF, E, wave); }
            skinny_phase<false>(lds, hbuf + (size_t)MP * D_FF, D_FF, W, D_FF, D_FF, 64, FResid{x32, 0.5f}, wave);
        }
        SEAM(pb + 1);
        if (IN(pb + 2)) { PH_BEGIN ln_phase(x32, xb, INP(11) + (size_t)(l * 4 + 0) * DM, INP(12) + (size_t)(l * 4 + 0) * DM, nullptr, gw, NGW, lane); }
        SEAM(pb + 2);
        if (IN(pb + 3)) {
            PH_BEGIN
            if constexpr (l == 0) {
                const FEvenIn f{outp, ws, INP(23), INP(24), INP(25)};
                { pg8::GridOrder S; S.init(xb, DM, WinE, DM, 32, 29, G, (int)blockIdx.x); pg8::EpiEach<FEvenIn> E{f}; pg8::gemm_phase(lds, S, DM, E, wave); }
                skinny_phase<false>(lds, xb + (size_t)MP * DM, DM, WinE, DM, DM, 232, f, wave);
            } else {
                const FOddIn f{outp, ws};
                { pg8::GridOrder S; S.init(xb, DM, WinO, DM, 32, 24, G, (int)blockIdx.x); pg8::EpiEach<FOddIn> E{f}; pg8::gemm_phase(lds, S, DM, E, wave); }
                skinny_phase<false>(lds, xb + (size_t)MP * DM, DM, WinO, DM, DM, 192, f, wave);
            }
        }
        SEAM(pb + 3);
        if (IN(pb + 4)) {
            PH_BEGIN
            const int cu = (int)blockIdx.x, rc = G - 1 - cu;
            if constexpr (l == 0) {
                LAS float* negc = (LAS float*)lds; LAS float* stmp = (LAS float*)(lds + 8192);
#pragma unroll 1
                for (int u = cu; u < 256; u += G) {
                    const int qb = 7 - (u >> 5), bh = u & 31, b = bh >> 3, h = bh & 7;
                    __syncthreads();
                    for (int e = tid; e < 512; e += NTHREADS) { f32x4 a;
#pragma unroll
                        for (int k4 = 0; k4 < 4; ++k4) a[k4] = outp[O_FLF + ((size_t)b * SEQ + 4 * e + k4) * H_A + h];
                        *(LAS f32x4*)(negc + 4 * e) = a; }
                    __syncthreads();
                    block_scan(negc, 2048, stmp, tid);
                    for (int e = tid; e < 2048; e += NTHREADS) negc[e] = -negc[e] * LOG2E;
                    __syncthreads();
                    attn_prompt_unit<false>(lds, qbuf, kbuf, vbuf, mrg, b, h * 128, h * 128, qb, negc, wave);
                }
                __syncthreads();
#pragma unroll 1
                for (int u = cu; u < 1024; u += G) hgrn_local_unit(lds, lfb, ibb, (float*)(ws + WS_DS), (float*)(ws + WS_DC), u, wave);
#pragma unroll 1
                for (int u = rc; u < 64; u += G) attn_sample_unit<false>(lds, qbuf, INP(3), INP(4), outp + O_FKS, outp + O_FVS, INP(5), outp + O_FLFS, mrg, u >> 3, u & 7, H_A, wave);
#pragma unroll 1
                for (int u = rc - 64; u >= 0 && u < 64; u += G) hgrn_sample_unit(lds, lfb, qbb, ibb, gbb, INP(6), outp + O_HSS, mrg, u, wave);
            } else {
#pragma unroll 1
                for (int u = cu; u < 512; u += G) {
                    const int uu = u & 255, bh = uu & 63, qb = u < 256 ? 7 - (uu >> 6) : (uu >> 6);
                    attn_prompt_unit<true>(lds, qbuf, kbuf, vbuf, mrg, bh >> 4, (bh & 15) * 128, (bh & 15) * 128, qb, nullptr, wave);
                }
#pragma unroll 1
                for (int u = rc; u < 128; u += G) attn_sample_unit<true>(lds, qbuf, INP(7), INP(8), outp + O_SKS, outp + O_SVS, nullptr, nullptr, mrg, u >> 4, u & 15, H_C, wave);
            }
        }
        SEAM(pb + 4);
        if (IN(pb + 5)) { PH_BEGIN if constexpr (l == 0) hgrn_scan_phase((const float*)(ws + WS_DS), (const float*)(ws + WS_DC), (bf16*)(ws + WS_SC), outp + O_HS, G, tid); }
        SEAM(pb + 5);
        if (IN(pb + 6)) { PH_BEGIN if constexpr (l == 0) {
#pragma unroll 1
            for (int u = (int)blockIdx.x; u < 1024; u += G) hgrn_out_unit(lds, lfb, qbb, ibb, gbb, (const bf16*)(ws + WS_SC), mrg, u, wave); } }
        SEAM(pb + 6);
        if (IN(pb + 7)) {
            PH_BEGIN
            const bf16* W = l == 0 ? WoutE : WoutO;
            { pg8::GridOrder S; S.init(mrg, DM, W, DM, 32, 8, G, (int)blockIdx.x); pg8::EpiEach<FResid> E{{x32, 1.0f}}; pg8::gemm_phase(lds, S, DM, E, wave); }
            skinny_phase<false>(lds, mrg + (size_t)MP * DM, DM, W, DM, DM, 64, FResid{x32, 1.0f}, wave);
        }
        SEAM(pb + 7);
        if (IN(pb + 8)) { PH_BEGIN ln_phase(x32, xb, INP(11) + (size_t)(l * 4 + 1) * DM, INP(12) + (size_t)(l * 4 + 1) * DM, nullptr, gw, NGW, lane); }
        SEAM(pb + 8);
        if (IN(pb + 9)) {
            PH_BEGIN
            const bf16* W = Wq + (size_t)l * DM * DM;
            { pg8::GridOrder S; S.init(xb, DM, W, DM, 32, 8, G, (int)blockIdx.x); pg8::EpiEach<FBf16> E{{qbuf, DM, QS512}}; pg8::gemm_phase(lds, S, DM, E, wave); }
            skinny_phase<false>(lds, xb + (size_t)MP * DM, DM, W, DM, DM, 64, FBf16{qbuf, DM, QS512}, wave);
        }
        SEAM(pb + 9);
        if (IN(pb + 10)) {
            PH_BEGIN
            { CrossSOrder S{qbuf, memK + (size_t)l * 1024 * DM, DM, DM, G, (int)blockIdx.x}; EpiSoftmax E{(bf16*)(ws + WS_P)}; pg8::gemm_phase(lds, S, HD_X, E, wave); }
#pragma unroll 1
            for (int u = G - 1 - (int)blockIdx.x; u < 32; u += G)
                cross_sample_unit(lds, qbuf, INP(9) + (size_t)l * DEC_B * N_MEM * DM, INP(10) + (size_t)l * DEC_B * N_MEM * DM, mrg, u >> 2, u & 3, wave);
        }
        SEAM(pb + 10);
        if (IN(pb + 11)) {
            PH_BEGIN
            CrossOOrder S{(const bf16*)(ws + WS_P), memVT + (size_t)l * DM * 1024, 1024, 1024, G, (int)blockIdx.x}; pg8::EpiEach<FCrossO> E{{mrg}}; pg8::gemm_phase(lds, S, N_MEM, E, wave);
        }
        SEAM(pb + 11);
        if (IN(pb + 12)) {
            PH_BEGIN
            const bf16* W = Wo + (size_t)l * DM * DM;
            { pg8::GridOrder S; S.init(mrg, DM, W, DM, 32, 8, G, (int)blockIdx.x); pg8::EpiEach<FResid> E{{x32, 1.0f}}; pg8::gemm_phase(lds, S, DM, E, wave); }
            skinny_phase<false>(lds, mrg + (size_t)MP * DM, DM, W, DM, DM, 64, FResid{x32, 1.0f}, wave);
        }
        SEAM(pb + 12);
        if (IN(pb + 13)) { PH_BEGIN ln_phase(x32, xb, INP(11) + (size_t)(l * 4 + 2) * DM, INP(12) + (size_t)(l * 4 + 2) * DM, nullptr, gw, NGW, lane); }
        SEAM(pb + 13);
        if (IN(pb + 14)) {
            PH_BEGIN
            const bf16* W = Wgu + (size_t)(2 * l + 1) * NGU * DM;
            { pg8::GridOrder S; S.init(xb, DM, W, DM, 32, 43, G, (int)blockIdx.x); pg8::EpiPair<FSwiglu> E{{hbuf}}; pg8::gemm_phase(lds, S, DM, E, wave); }
            skinny_phase<true>(lds, xb + (size_t)MP * DM, DM, W, DM, DM, 344, FSwiglu{hbuf}, wave);
        }
        SEAM(pb + 14);
        if (IN(pb + 15)) {
            PH_BEGIN
            const bf16* W = Wd + (size_t)(2 * l + 1) * DM * D_FF;
            { pg8::GridOrder S; S.init(hbuf, D_FF, W, D_FF, 32, 8, G, (int)blockIdx.x); pg8::EpiEach<FResid> E{{x32, 0.5f}}; pg8::gemm_phase(lds, S, D_FF, E, wave); }
            skinny_phase<false>(lds, hbuf + (size_t)MP * D_FF, D_FF, W, D_FF, D_FF, 64, FResid{x32, 0.5f}, wave);
        }
        SEAM(pb + 15);
        if (IN(pb + 16)) { PH_BEGIN ln_phase(x32, xb, INP(11) + (size_t)(l * 4 + 3) * DM, INP(12) + (size_t)(l * 4 + 3) * DM, l == 1 ? outp + O_Y : nullptr, gw, NGW, lane); }
        SEAM(pb + 16);
    }
__global__ void __launch_bounds__(NTHREADS, 2) fwd(Args args) {
    extern __shared__ __attribute__((aligned(16))) unsigned char lds_raw[];
    LAS unsigned char* lds = (LAS unsigned char*)lds_raw;
    const int tid0 = threadIdx.x, wave = __builtin_amdgcn_readfirstlane(tid0 >> 6);
    const int G = gridDim.x;
    unsigned* ctl = (unsigned*)(args.ws + WS_CTL);
    volatile LAS unsigned* MISC = (volatile LAS unsigned*)(lds + MISC_OFF);
    for (int u = tid0; u < (LDS_BYTES - RING_BYTES) / 4; u += NTHREADS) ((LAS unsigned*)(lds + RING_BYTES))[u] = 0u;
    __syncthreads();
    const int lo = args.ph_lo, hi = args.ph_hi;
    const bool multi = (hi - lo) > 1;
    XcdBarrier bar; bar.bar = ctl + CW_BAR; bar.x = 0; bar.st = nullptr;
    if (multi) bar = xcd_barrier_post(ctl + CW_BAR, MISC + 8);
    bar.wv = wave;

    const int gw = blockIdx.x * NWAVES + wave, NGW = G * NWAVES;
    if (IN(0)) {
        PH_BEGIN
        LAS float* scr = (LAS float*)(lds + wave * 16384);
        constexpr int I_GU = 32 * 172, I_D = 86 * 64, I_22 = 32 * 64, I_KV = 32 * 128, I_INE = 32 * 225, I_INO = 32 * 192;
        constexpr int PER_L = 6 * I_GU + 2 * I_22 + I_KV;
        constexpr int NITEMS = 2 * PER_L + I_INE + I_22 + I_INO + I_22;
        static_assert(I_GU == I_D, "items");
#pragma unroll 1
        for (int it = gw; it < NITEMS; it += NGW) {
            int r = it;
            if (r < 2 * PER_L) {
                const int l = r / PER_L; r -= l * PER_L;
                if (r < I_GU) { transpose_item<1>(INP(13) + (size_t)l * DM * D_FF, DM, D_FF, Wgu + (size_t)(2 * l) * NGU * DM, scr, r, lane); continue; } r -= I_GU;
                if (r < I_GU) { transpose_item<2>(INP(14) + (size_t)l * DM * D_FF, DM, D_FF, Wgu + (size_t)(2 * l) * NGU * DM, scr, r, lane); continue; } r -= I_GU;
                if (r < I_D) { transpose_item<0>(INP(15) + (size_t)l * DM * D_FF, D_FF, DM, Wd + (size_t)(2 * l) * DM * D_FF, scr, r, lane); continue; } r -= I_D;
                if (r < I_GU) { transpose_item<1>(INP(16) + (size_t)l * DM * D_FF, DM, D_FF, Wgu + (size_t)(2 * l + 1) * NGU * DM, scr, r, lane); continue; } r -= I_GU;
                if (r < I_GU) { transpose_item<2>(INP(17) + (size_t)l * DM * D_FF, DM, D_FF, Wgu + (size_t)(2 * l + 1) * NGU * DM, scr, r, lane); continue; } r -= I_GU;
                if (r < I_D) { transpose_item<0>(INP(18) + (size_t)l * DM * D_FF, D_FF, DM, Wd + (size_t)(2 * l + 1) * DM * D_FF, scr, r, lane); continue; } r -= I_D;
                if (r < I_22) { transpose_item<0>(INP(19) + (size_t)l * DM * DM, DM, DM, Wq + (size_t)l * DM * DM, scr, r, lane); continue; } r -= I_22;
                if (r < I_KV) { transpose_item<0>(INP(20) + (size_t)l * DM * 2 * DM, DM, 2 * DM, Wkv + (size_t)l * 2 * DM * DM, scr, r, lane); continue; } r -= I_KV;
                transpose_item<0>(INP(21) + (size_t)l * DM * DM, DM, DM, Wo + (size_t)l * DM * DM, scr, r, lane); continue;
            }
            r -= 2 * PER_L;
            if (r < I_INE) { transpose_item<3>(INP(22), DM, D_IN_EVEN, WinE, scr, r, lane); continue; } r -= I_INE;
            if (r < I_22) { transpose_item<0>(INP(26), DM, DM, WoutE, scr, r, lane); continue; } r -= I_22;
            if (r < I_INO) { transpose_item<0>(INP(27), DM, D_IN_ODD, WinO, scr, r, lane); continue; } r -= I_INO;
            transpose_item<0>(INP(28), DM, DM, WoutO, scr, r, lane);
        }
        for (int i = gw * 64 + lane; i < (NE - D_IN_EVEN) * DM / 8; i += NGW * 64) *(u32x4*)(WinE + (size_t)D_IN_EVEN * DM + (size_t)i * 8) = (u32x4){0u, 0u, 0u, 0u};
#pragma unroll 1
        for (int m = gw; m < MT + 1024; m += NGW) {
            const float* src; float* d32 = nullptr; bf16* d16;
            if (m < MP) { src = INP(0) + (size_t)m * DM; d32 = x32 + (size_t)m * DM; d16 = xb + (size_t)m * DM; }
            else if (m < MT) { src = INP(1) + (size_t)(m - MP) * DM; d32 = x32 + (size_t)m * DM; d16 = xb + (size_t)m * DM; }
            else { src = INP(2) + (size_t)(m - MT) * DM; d16 = memb + (size_t)(m - MT) * DM; }
#pragma unroll
            for (int j = 0; j < 8; ++j) { const f32x4 v = *(const f32x4*)(src + (lane + 64 * j) * 4); if (d32) *(f32x4*)(d32 + (lane + 64 * j) * 4) = v;
                u32x2 w; w.x = pk2(v[0], v[1]); w.y = pk2(v[2], v[3]); *(u32x2*)(d16 + (lane + 64 * j) * 4) = w; }
        }
    }
    SEAM(0);
    if (IN(1)) {
        PH_BEGIN
#pragma unroll 1
        for (int l = 0; l < 2; ++l) {
            { pg8::GridOrder S; S.init(memb, DM, Wkv + (size_t)l * 2 * DM * DM, DM, 4, 16, G, (int)blockIdx.x);
              pg8::EpiEach<FMemKV> E{{outp + O_MK + (size_t)l * 1024 * DM, outp + O_MV + (size_t)l * 1024 * DM, memK + (size_t)l * 1024 * DM}};
              pg8::gemm_phase(lds, S, DM, E, wave); }
            { pg8::GridOrder S; S.init(Wkv + (size_t)l * 2 * DM * DM + (size_t)DM * DM, DM, memb, DM, 8, 4, G, (int)blockIdx.x);
              pg8::EpiEach<FBf16> E{{memVT + (size_t)l * DM * 1024, 1024, 1.0f}};
              pg8::gemm_phase(lds, S, DM, E, wave); }
        }
    }
    SEAM(1);
    layer_body<0>(args, lds, wave, G, lo, hi, bar);
    layer_body<1>(args, lds, wave, G, lo, hi, bar);
#undef IN
#undef SEAM
}

constexpr int N_PHASES = 2 + 2 * PH_PER_LAYER;

extern "C" void kernel_launch(void* const* d_in, const int* in_sizes, int n_in, void* d_out, int out_size, void* d_ws, size_t ws_size, hipStream_t stream) {
    static int grid = 0;
    if (grid == 0) {
        if (n_in != 29 || (size_t)out_size != O_END || ws_size < WS_END) { fprintf(stderr, "kernel_launch: unexpected sizes n_in %d out %d ws %zu (need %zu)\n", n_in, out_size, ws_size, (size_t)WS_END); grid = -1; return; }
        int dev = 0, cus = 0, per_cu = 0;
        if (hipGetDevice(&dev) != hipSuccess || hipDeviceGetAttribute(&cus, hipDeviceAttributeMultiprocessorCount, dev) != hipSuccess) { grid = -1; return; }
        if (hipFuncSetAttribute((const void*)fwd, hipFuncAttributeMaxDynamicSharedMemorySize, LDS_BYTES) != hipSuccess) { fprintf(stderr, "kernel_launch: hipFuncSetAttribute failed\n"); grid = -1; return; }
        if (hipOccupancyMaxActiveBlocksPerMultiprocessor(&per_cu, (const void*)fwd, NTHREADS, LDS_BYTES) != hipSuccess || per_cu < 1) fprintf(stderr, "kernel_launch: occupancy query says %d\n", per_cu);
        (void)hipGetLastError();
        grid = cus;
    }
    if (grid < 0) return;
    (void)hipMemsetAsync((char*)d_ws + WS_CTL, 0, CTL_ZERO_BYTES, stream);
    Args a{};
    for (int i = 0; i < 29; ++i) a.in[i] = (const float*)d_in[i];
    a.out = (float*)d_out; a.ws = (unsigned char*)d_ws;
#ifdef MULTI_LAUNCH
    for (int p = 0; p < N_PHASES; ++p) { a.ph_lo = p; a.ph_hi = p + 1; hipLaunchKernelGGL(fwd, dim3(grid), dim3(NTHREADS), LDS_BYTES, stream, a); }
#else
    a.ph_lo = 0; a.ph_hi = N_PHASES; hipLaunchKernelGGL(fwd, dim3(grid), dim3(NTHREADS), LDS_BYTES, stream, a);
#endif
}
```

```cpp
#include <hip/hip_runtime.h>
#include <cstdio>
#include <cstdint>

#define LAS __attribute__((address_space(3)))
#define GAS __attribute__((address_space(1)))
typedef unsigned short bf16;
typedef short bf16x8 __attribute__((ext_vector_type(8)));
typedef short s16x4 __attribute__((ext_vector_type(4)));
typedef float f32x4 __attribute__((ext_vector_type(4)));
typedef float f32x2 __attribute__((ext_vector_type(2)));
typedef float f32x16 __attribute__((ext_vector_type(16)));
typedef unsigned u32x4 __attribute__((ext_vector_type(4)));
typedef unsigned u32x2 __attribute__((ext_vector_type(2)));
#define DI __device__ __forceinline__
__device__ __forceinline__ int lane_id_() { int l; asm volatile("v_mbcnt_lo_u32_b32 %0, -1, 0\n\tv_mbcnt_hi_u32_b32 %0, -1, %0" : "=v"(l)); return l; }

constexpr int DM = 2048, BATCH = 4, SEQ = 2048, DEC_B = 8, DEC_T = 16, PAST = 1024;
constexpr int MP = BATCH * SEQ;
constexpr int MS = DEC_B * DEC_T;
constexpr int MT = MP + MS;
constexpr int HD = 128, H_A = 8, W_A = 1024, H_B = 8, W_B = 1024, H_C = 16, W_C = 2048, H_X = 4, HD_X = 512, N_MEM = 256;
constexpr int D_FF = 5504, NGU = 2 * D_FF;
constexpr int D_IN_EVEN = 7176, NE = 7424;
constexpr int D_IN_ODD = 6144;
constexpr float ALPHA = 1.41421356237309515f;
constexpr float LN_EPS = 1e-5f, RMS_EPS = 1e-6f;
constexpr float LOG2E = 1.4426950408889634f, LN2 = 0.6931471805599453f;

constexpr size_t O_Y = 0, O_YS = O_Y + (size_t)MP * DM, O_FK = O_YS + (size_t)MS * DM, O_FV = O_FK + (size_t)MP * W_A, O_FLF = O_FV + (size_t)MP * W_A,
    O_HS = O_FLF + (size_t)MP * H_A, O_SK = O_HS + (size_t)BATCH * H_B * 128 * 128, O_SV = O_SK + (size_t)MP * W_C, O_MK = O_SV + (size_t)MP * W_C,
    O_MV = O_MK + (size_t)2 * BATCH * N_MEM * DM, O_FKS = O_MV + (size_t)2 * BATCH * N_MEM * DM, O_FVS = O_FKS + (size_t)MS * W_A, O_FLFS = O_FVS + (size_t)MS * W_A,
    O_HSS = O_FLFS + (size_t)MS * H_A, O_SKS = O_HSS + (size_t)DEC_B * H_B * 128 * 128, O_SVS = O_SKS + (size_t)MS * W_C, O_END = O_SVS + (size_t)MS * W_C;

constexpr size_t MiB = 1u << 20;
constexpr size_t al(size_t x) { return (x + 255) & ~(size_t)255; }
constexpr size_t WS_CTL = 0, CTL_ZERO_BYTES = 1 * MiB;
constexpr size_t SZ_WGU = (size_t)NGU * DM * 2, SZ_WD = (size_t)DM * D_FF * 2, SZ_W22 = (size_t)DM * DM * 2, SZ_WKV = (size_t)2 * DM * DM * 2;
constexpr size_t WS_WGU = 2 * MiB;
constexpr size_t WS_WD = WS_WGU + 4 * SZ_WGU;
constexpr size_t WS_WQ = WS_WD + 4 * SZ_WD;
constexpr size_t WS_WKV = WS_WQ + 2 * SZ_W22;
constexpr size_t WS_WO = WS_WKV + 2 * SZ_WKV;
constexpr size_t WS_WINE = WS_WO + 2 * SZ_W22;
constexpr size_t WS_WOUTE = WS_WINE + (size_t)NE * DM * 2;
constexpr size_t WS_WINO = WS_WOUTE + SZ_W22;
constexpr size_t WS_WOUTO = WS_WINO + (size_t)D_IN_ODD * DM * 2;
constexpr size_t WS_X32 = al(WS_WOUTO + SZ_W22);
constexpr size_t WS_XB = al(WS_X32 + (size_t)MT * DM * 4);
constexpr size_t WS_H = al(WS_XB + (size_t)(MT + 128) * DM * 2);
constexpr size_t WS_MRG = al(WS_H + (size_t)MT * D_FF * 2);
constexpr size_t WS_Q = al(WS_MRG + (size_t)MT * DM * 2);
constexpr size_t WS_KB = al(WS_Q + (size_t)MT * DM * 2);
constexpr size_t WS_VB = al(WS_KB + (size_t)MP * DM * 2);
constexpr size_t WS_QBB = al(WS_VB + (size_t)MP * DM * 2);
constexpr size_t WS_IBB = al(WS_QBB + (size_t)MT * W_B * 2);
constexpr size_t WS_GBB = al(WS_IBB + (size_t)MT * W_B * 2);
constexpr size_t WS_LFB = al(WS_GBB + (size_t)MT * W_B * 2);
constexpr size_t WS_MEMB = al(WS_LFB + (size_t)MT * W_B * 4);
constexpr size_t WS_MEMK = al(WS_MEMB + (size_t)1024 * DM * 2);
constexpr size_t WS_MEMVT = al(WS_MEMK + (size_t)2 * 1024 * DM * 2);
constexpr size_t WS_P = al(WS_MEMVT + (size_t)2 * 1024 * DM * 2);
constexpr size_t WS_DS = al(WS_P + (size_t)MP * 1024 * 2);
constexpr size_t WS_DC = al(WS_DS + (size_t)1024 * 128 * 128 * 4);
constexpr size_t WS_SC = al(WS_DC + (size_t)1024 * 128 * 4);
constexpr size_t WS_PART = al(WS_SC + (size_t)1024 * 128 * 128 * 2);
constexpr size_t WS_END = al(WS_PART + (size_t)4 * MS * DM * 4);

constexpr int CW_TMO = 0;
constexpr int CW_BAR = 4096;

constexpr int RING_BYTES = 131072;
constexpr int MISC_OFF = 139264;
constexpr int LDS_BYTES = 147456;
constexpr int NWAVES = 8, NTHREADS = 512;
constexpr int PH_PER_LAYER = 17;

#define LDS_WAIT() asm volatile("s_waitcnt lgkmcnt(0)" ::: "memory")
#define VM_WAIT() asm volatile("s_waitcnt vmcnt(0)" ::: "memory")
DI unsigned f2bf(float f) { unsigned u = __builtin_bit_cast(unsigned, f); return (u + 0x7fffu + ((u >> 16) & 1u)) >> 16; }
DI unsigned pk2(float lo, float hi) { unsigned r; asm volatile("v_cvt_pk_bf16_f32 %0, %1, %2" : "=v"(r) : "v"(lo), "v"(hi)); return r; }
DI float bf2f(unsigned short b) { return __builtin_bit_cast(float, (unsigned)b << 16); }
DI float wave_sum(float v) {
#pragma unroll
    for (int o = 1; o < 64; o <<= 1) v += __shfl_xor(v, o);
    return v;
}
DI float fexp2(float x) { return __builtin_amdgcn_exp2f(x); }
DI float flog2(float x) { return __builtin_amdgcn_logf(x); }
DI float sigmoidf_(float x) { return 1.0f / (1.0f + __expf(-x)); }
DI float siluf_(float x) { return x / (1.0f + __expf(-x)); }
DI float logsigmoidf_(float x) { return fminf(x, 0.f) - log1pf(__expf(-fabsf(x))); }

#define XB_TMO      128
#define XB_XCNT(j)  (256  + 64 * (j))
#define XB_XSUB(j)  (1280 + 64 * (j))
#define XB_XGEN(j)  (2304 + 64 * (j))
#define XB_TOP      3328
#define XB_TOPGEN   3392
#define XCD_BAR_WORDS 3456
#define XB_SPIN_CAP (1u << 18)
__device__ __forceinline__ unsigned xb_ld(unsigned* p)              { return __hip_atomic_load(p, __ATOMIC_RELAXED, __HIP_MEMORY_SCOPE_AGENT); }
__device__ __forceinline__ unsigned xb_add(unsigned* p, unsigned v) { return __hip_atomic_fetch_add(p, v, __ATOMIC_RELAXED, __HIP_MEMORY_SCOPE_AGENT); }
__device__ __forceinline__ unsigned xb_xcc_id() { return (unsigned)__builtin_amdgcn_s_getreg((3 << 11) | 20) & 0xFu; }
#define XB_SPIN(cond, bar) do { unsigned _sp = 0; while (cond) { __builtin_amdgcn_s_sleep(1); \
    if ((++_sp & 255u) == 0u) { if (xb_ld(&(bar)[XB_TMO])) break; if (_sp > XB_SPIN_CAP) { atomicAdd(&(bar)[XB_TMO], 1u); break; } } } } while (0)
struct XcdBarrier { unsigned* bar; unsigned x; volatile LAS unsigned* st; int wv; };
__device__ __forceinline__ XcdBarrier xcd_barrier_post(unsigned* bar, volatile LAS unsigned* st) {
    XcdBarrier b; b.bar = bar; b.x = xb_xcc_id(); b.st = st;
    if (threadIdx.x == 0) (void)xb_add(&bar[XB_XCNT(b.x)], 1u);
    return b;
}
__device__ __forceinline__ void xcd_barrier_complete(unsigned* bar, unsigned x, unsigned& nloc, unsigned& nx) {
    const unsigned G = gridDim.x * gridDim.y * gridDim.z;
    unsigned sum, cnt, mine, sp = 0u;
    for (;;) {
        sum = 0u; cnt = 0u; mine = 0u;
#pragma unroll
        for (unsigned j = 0; j < 16; ++j) { const unsigned c = xb_ld(&bar[XB_XCNT(j)]); sum += c; cnt += (c > 0u) ? 1u : 0u; mine = (j == x) ? c : mine; }
        if (sum == G) break;
        __builtin_amdgcn_s_sleep(1);
        if ((++sp & 255u) == 0u) { if (xb_ld(&bar[XB_TMO])) break; if (sp > XB_SPIN_CAP) { atomicAdd(&bar[XB_TMO], 1u); break; } }
    }
    nloc = mine > 0u ? mine : 1u; nx = cnt > 0u ? cnt : 1u;
}
__device__ __forceinline__ void xcd_barrier(const XcdBarrier& b) {
    asm volatile("s_waitcnt vmcnt(0)" ::: "memory");
    __syncthreads();
    if (b.wv == 0 && lane_id_() == 0) {
        size_t zb = 0; asm volatile("" : "+s"(zb)); unsigned* bar = b.bar + zb;
        __builtin_amdgcn_s_waitcnt(0);
        unsigned nloc = b.st[0], nx = b.st[1];
        unsigned bx = b.x; asm volatile("" : "+s"(bx));
        if (nloc == 0u) { xcd_barrier_complete(bar, bx, nloc, nx); b.st[0] = nloc; b.st[1] = nx; }
        const unsigned old = xb_add(&bar[XB_XSUB(bx)], 1u);
        const unsigned gen = old / nloc;
        if (old + 1u == (gen + 1u) * nloc) {
            __builtin_amdgcn_fence(__ATOMIC_RELEASE, "agent");
            asm volatile("s_waitcnt vmcnt(0)" ::: "memory");
            const unsigned og = xb_add(&bar[XB_TOP], 1u);
            const unsigned tg = og / nx;
            if (og + 1u == (tg + 1u) * nx) xb_add(&bar[XB_TOPGEN], 1u);
            else XB_SPIN(xb_ld(&bar[XB_TOPGEN]) == tg, bar);
            __builtin_amdgcn_fence(__ATOMIC_ACQUIRE, "agent");
            xb_add(&bar[XB_XGEN(bx)], 1u);
            asm volatile("s_waitcnt vmcnt(0)" ::: "memory");
        } else {
            XB_SPIN(xb_ld(&bar[XB_XGEN(bx)]) == gen, bar);
            __builtin_amdgcn_fence(__ATOMIC_ACQUIRE, "agent");
            asm volatile("s_waitcnt vmcnt(0)" ::: "memory");
        }
    }
    __syncthreads();
}

namespace pg8 {
constexpr int BM = 256, BK = 64, HALF = 128, HTB = HALF * BK * 2, STAGE_BYTES = 8 * HTB, NXCD = 8, WGM = 8;
DI int lds_byte(int r, int c) { const int st = (r >> 4) * 2 + (c >> 5), rr = r & 15, cc = c & 31, ob = rr * 64 + cc * 2; return st * 1024 + (ob ^ (((ob >> 9) & 1) << 5)); }
DI void stage_rc(int b, int& R, int& C) { const int st = b / 1024, sb = b % 1024, swz = sb ^ (((sb >> 9) & 1) << 5); R = (st >> 1) * 16 + swz / 64; C = (st & 1) * 32 + (swz % 64) / 2; }
struct Unit { int pm, pn, z; };
struct GridOrder {
    const bf16* A; const bf16* Bt; int lda, ldb; int nM, nN, nwg, G, c;
    DI void init(const bf16* A_, int lda_, const bf16* Bt_, int ldb_, int nM_, int nN_, int G_, int c_) { A = A_; Bt = Bt_; lda = lda_; ldb = ldb_; nM = nM_; nN = nN_; nwg = nM * nN; G = G_; c = c_; }
    DI bool next(int i, Unit& u) const {
        const long L = (long)i * G + c; if (c < 0 || L >= nwg) return false;
        int wgid = (int)L; { const int q = nwg / NXCD, r = nwg % NXCD, xcd = wgid % NXCD, off = wgid / NXCD; wgid = (xcd < r ? xcd * (q + 1) : r * (q + 1) + (xcd - r) * q) + off; }
        const int nig = WGM * nN, gid = wgid / nig, fm = gid * WGM, gsz = (nM - fm) < WGM ? (nM - fm) : WGM;
        u.pm = fm + ((wgid % nig) % gsz); u.pn = (wgid % nig) / gsz; u.z = 0; return true;
    }
    DI const char* pa(const Unit& u) const { return (const char*)(A + (size_t)u.pm * 256 * lda); }
    DI const char* pb(const Unit& u) const { return (const char*)(Bt + (size_t)u.pn * 256 * ldb); }
};

template <class Epi, class Sched>
__device__ __forceinline__ void gemm_phase(LAS unsigned char* lds, const Sched& S, const int K, const Epi& E, const int wv_) {
    const int tid = wv_ * 64 + lane_id_();
    const int wid = __builtin_amdgcn_readfirstlane(tid >> 6), lane = tid & 63, wr = wid >> 2, wc = wid & 3, fr = lane & 15, fq = lane >> 4;
    const int nt = K / BK;
    const int lda = S.lda, ldb = S.ldb;
    unsigned voffA[2], voffB[2];
#pragma unroll
    for (int i = 0; i < 2; ++i) { int R, C; stage_rc(tid * 16 + i * 8192, R, C);
        voffA[i] = (unsigned)(R * lda + C) * 2u; voffB[i] = (unsigned)(R * ldb + C) * 2u; }
    const size_t kstep = (size_t)(BK * 2);
    const size_t hstepA = (size_t)HALF * lda * 2, hstepB = (size_t)HALF * ldb * 2;
    const unsigned ldsw = (unsigned)wid * 1024u;
    const int aoff = lds_byte(wr * 64 + fr, fq * 8), boff = lds_byte(wc * 32 + fr, fq * 8);
#define PG8_SA(b, h) (((b) * 2 + (h)) * HTB)
#define PG8_SB(b, h) ((4 + (b) * 2 + (h)) * HTB)
#define PG8_STAGE(bufoff, gbase, voff) do { _Pragma("unroll") for (int _i = 0; _i < 2; ++_i) \
        __builtin_amdgcn_global_load_lds((const unsigned*)((const char*)(gbase) + (voff)[_i]), (LAS unsigned*)(lds + (bufoff) + ldsw + _i * 8192), 16, 0, 0); } while (0)
#define PG8_LDA(dst, b, h) do { _Pragma("unroll") for (int m = 0; m < 4; ++m) _Pragma("unroll") for (int k = 0; k < 2; ++k) dst[m][k] = *(const LAS bf16x8*)(lds + PG8_SA(b, h) + aoff + m * 2048 + k * 1024); } while (0)
#define PG8_LDB(dst, b, h) do { _Pragma("unroll") for (int n = 0; n < 2; ++n) _Pragma("unroll") for (int k = 0; k < 2; ++k) dst[n][k] = *(const LAS bf16x8*)(lds + PG8_SB(b, h) + boff + n * 2048 + k * 1024); } while (0)
#define PG8_MMA(ai, bj, At, Bt) do { __builtin_amdgcn_s_setprio(1); _Pragma("unroll") for (int m = 0; m < 4; ++m) _Pragma("unroll") for (int n = 0; n < 2; ++n) _Pragma("unroll") for (int k = 0; k < 2; ++k) \
        acc[ai][bj][m][n] = __builtin_amdgcn_mfma_f32_16x16x32_bf16(Bt[n][k], At[m][k], acc[ai][bj][m][n], 0, 0, 0); __builtin_amdgcn_s_setprio(0); } while (0)
#define PG8_WAIT_V(n) asm volatile("s_waitcnt vmcnt(" #n ")" ::: "memory")
#define PG8_WAIT_L(n) asm volatile("s_waitcnt lgkmcnt(" #n ")" ::: "memory")
#define PG8_BAR __builtin_amdgcn_s_barrier()
#define PG8_SCHED __builtin_amdgcn_sched_barrier(0)
    Unit cur, nxt; int ui = 0;
    if (!S.next(0, cur)) return;
    f32x4 acc[2][2][4][2];
#pragma unroll
    for (int a = 0; a < 2; ++a)
#pragma unroll
        for (int b = 0; b < 2; ++b)
#pragma unroll
            for (int m = 0; m < 4; ++m)
#pragma unroll
                for (int n = 0; n < 2; ++n) acc[a][b][m][n] = (f32x4){0.f, 0.f, 0.f, 0.f};
    bf16x8 At[4][2], B0[2][2], B1[2][2];
    const char* cA = S.pa(cur); const char* cB = S.pb(cur);
    {
        PG8_STAGE(PG8_SB(0, 0), cB, voffB); PG8_STAGE(PG8_SB(0, 1), cB + hstepB, voffB); PG8_STAGE(PG8_SA(0, 0), cA, voffA); PG8_STAGE(PG8_SA(0, 1), cA + hstepA, voffA);
        if (wr == 1) PG8_BAR;
        PG8_WAIT_V(2); PG8_BAR;
        PG8_STAGE(PG8_SB(1, 0), cB + kstep, voffB); PG8_STAGE(PG8_SA(1, 0), cA + kstep, voffA); PG8_STAGE(PG8_SB(1, 1), cB + hstepB + kstep, voffB);
        PG8_WAIT_V(6); PG8_BAR;
    }
    for (;;) {
        const bool has_next = S.next(ui + 1, nxt);
        const char* nA = has_next ? S.pa(nxt) : cA; const char* nB = has_next ? S.pb(nxt) : cB;
        for (int t = 0; t < nt; t += 2) {
            const bool last = (t == nt - 2);
            const char* a1 = cA + (size_t)(t + 1) * kstep;
            const char* a2 = last ? nA : cA + (size_t)(t + 2) * kstep; const char* b2 = last ? nB : cB + (size_t)(t + 2) * kstep;
            const char* a3 = a2 + kstep; const char* b3 = b2 + kstep;
            PG8_LDB(B0, 0, 0); PG8_LDB(B1, 0, 1); PG8_SCHED; PG8_LDA(At, 0, 0); PG8_STAGE(PG8_SA(1, 1), a1 + hstepA, voffA);
            PG8_WAIT_V(8); PG8_WAIT_L(0); PG8_BAR; PG8_MMA(0, 0, At, B0); PG8_MMA(0, 1, At, B1); PG8_BAR; PG8_SCHED;
            PG8_LDA(At, 0, 1); PG8_STAGE(PG8_SB(0, 0), b2, voffB); PG8_STAGE(PG8_SB(0, 1), b2 + hstepB, voffB); PG8_STAGE(PG8_SA(0, 0), a2, voffA);
            PG8_WAIT_V(8); PG8_WAIT_L(0); PG8_BAR; PG8_MMA(1, 0, At, B0); PG8_MMA(1, 1, At, B1); PG8_BAR; PG8_SCHED;
            PG8_LDB(B0, 1, 0); PG8_LDB(B1, 1, 1); PG8_SCHED; PG8_LDA(At, 1, 0); PG8_STAGE(PG8_SA(0, 1), a2 + hstepA, voffA);
            PG8_WAIT_V(8); PG8_WAIT_L(0); PG8_BAR; PG8_MMA(0, 0, At, B0); PG8_MMA(0, 1, At, B1); PG8_BAR; PG8_SCHED;
            PG8_LDA(At, 1, 1); PG8_STAGE(PG8_SB(1, 0), b3, voffB); PG8_STAGE(PG8_SB(1, 1), b3 + hstepB, voffB); PG8_STAGE(PG8_SA(1, 0), a3, voffA);
            PG8_WAIT_V(8); PG8_WAIT_L(0); PG8_BAR; PG8_MMA(1, 0, At, B0); PG8_MMA(1, 1, At, B1); PG8_BAR; PG8_SCHED;
        }
        if (wr == 0) PG8_BAR;
        if constexpr (!Epi::AFTER_DRAIN) { E(acc, cur, wr, wc, fr, fq); }
        if (!has_next) break;
#pragma unroll
        for (int a = 0; a < 2; ++a)
#pragma unroll
            for (int b = 0; b < 2; ++b)
#pragma unroll
                for (int m = 0; m < 4; ++m)
#pragma unroll
                    for (int n = 0; n < 2; ++n) acc[a][b][m][n] = (f32x4){0.f, 0.f, 0.f, 0.f};
        cur = nxt; cA = nA; cB = nB; ++ui;
        if (wr == 1) PG8_BAR;
    }
    PG8_WAIT_V(0);
    PG8_BAR;
    if constexpr (Epi::AFTER_DRAIN) { E.fused(acc, cur, wr, wc, fr, fq, lds, wid, lane); }
#undef PG8_SA
#undef PG8_SB
#undef PG8_STAGE
#undef PG8_LDA
#undef PG8_LDB
#undef PG8_MMA
#undef PG8_WAIT_V
#undef PG8_WAIT_L
#undef PG8_BAR
#undef PG8_SCHED
}

template <class F, bool GUARD = false> struct EpiEach {
    static constexpr bool AFTER_DRAIN = false;
    F f;
    DI void operator()(const f32x4 (&acc)[2][2][4][2], const Unit& u, int wr, int wc, int fr, int fq) const {
#pragma unroll
        for (int ai = 0; ai < 2; ++ai)
#pragma unroll
            for (int m = 0; m < 4; ++m) { const int row = u.pm * BM + ai * HALF + wr * 64 + m * 16 + fr;
#pragma unroll
                for (int bj = 0; bj < 2; ++bj)
#pragma unroll
                    for (int n = 0; n < 2; ++n) if (!GUARD || row < MT) f.apply4(u, row, u.pn * BM + bj * HALF + wc * 32 + n * 16 + 4 * fq, acc[ai][bj][m][n]);
                asm volatile("" ::: "memory"); }
    }
};
template <class F, bool GUARD = false> struct EpiPair {
    static constexpr bool AFTER_DRAIN = false;
    F f;
    DI void operator()(const f32x4 (&acc)[2][2][4][2], const Unit& u, int wr, int wc, int fr, int fq) const {
#pragma unroll
        for (int ai = 0; ai < 2; ++ai)
#pragma unroll
            for (int m = 0; m < 4; ++m) { const int row = u.pm * BM + ai * HALF + wr * 64 + m * 16 + fr;
#pragma unroll
                for (int n = 0; n < 2; ++n) if (!GUARD || row < MT) f.pair4(row, u.pn * HALF + wc * 32 + n * 16 + 4 * fq, acc[ai][0][m][n], acc[ai][1][m][n]);
                asm volatile("" ::: "memory"); }
    }
};
}

template <bool PAIR, int KSPLIT, class F>
__device__ __forceinline__ void skinny_phase(LAS unsigned char* lds, const bf16* A, int lda, const bf16* Bt, int ldb, int K, int nunits, const F& f, const int wv_, const int cu0, const int ncu) {
    const int tid = wv_ * 64 + lane_id_();
    const int wid = __builtin_amdgcn_readfirstlane(tid >> 6), lane = tid & 63, l15 = lane & 15, lq = lane >> 4;
    const int c = (int)blockIdx.x - cu0;
    const int nks = K / 32;
    if (c < 0 || c >= ncu) return;
    for (int jj = c; jj < nunits; jj += ncu) {
        const int ksl = jj % KSPLIT, j = jj / KSPLIT;
        const int sl0 = (ksl * nks) / KSPLIT, sl1 = ((ksl + 1) * nks) / KSPLIT;
        const int ks0 = sl0 + (wid * (sl1 - sl0)) / 8, ks1 = sl0 + ((wid + 1) * (sl1 - sl0)) / 8;
        int c0, c1;
        if (PAIR) { c0 = (j >> 3) * 256 + (j & 7) * 16; c1 = c0 + 128; } else { c0 = 32 * j; c1 = c0 + 16; }
        f32x4 acc[2][8];
#pragma unroll
        for (int nb = 0; nb < 2; ++nb)
#pragma unroll
            for (int i = 0; i < 8; ++i) acc[nb][i] = (f32x4){0.f, 0.f, 0.f, 0.f};
        const bf16* w0 = Bt + (size_t)(c0 + l15) * ldb + lq * 8;
        const bf16* w1 = Bt + (size_t)(c1 + l15) * ldb + lq * 8;
        const bf16* ap = A + (size_t)l15 * lda + lq * 8;
#pragma unroll 3
        for (int ks = ks0; ks < ks1; ++ks) {
            const bf16x8 wa = *(const bf16x8*)(w0 + ks * 32), wb = *(const bf16x8*)(w1 + ks * 32);
            bf16x8 xa[8];
#pragma unroll
            for (int i = 0; i < 8; ++i) xa[i] = *(const bf16x8*)(ap + (size_t)(16 * i) * lda + ks * 32);
#pragma unroll
            for (int i = 0; i < 8; ++i) { acc[0][i] = __builtin_amdgcn_mfma_f32_16x16x32_bf16(wa, xa[i], acc[0][i], 0, 0, 0); acc[1][i] = __builtin_amdgcn_mfma_f32_16x16x32_bf16(wb, xa[i], acc[1][i], 0, 0, 0); }
        }
        __syncthreads();
#pragma unroll
        for (int nb = 0; nb < 2; ++nb)
#pragma unroll
            for (int i = 0; i < 8; ++i) *(LAS f32x4*)(lds + ((((wid * 2 + nb) * 8 + i) * 64 + lane) * 16)) = acc[nb][i];
        __syncthreads();
        {
            const int i = tid >> 6, lp = tid & 63;
            f32x4 v0 = (f32x4){0.f, 0.f, 0.f, 0.f}, v1 = v0;
#pragma unroll
            for (int w = 0; w < 8; ++w) { v0 += *(const LAS f32x4*)(lds + ((((w * 2 + 0) * 8 + i) * 64 + lp) * 16)); v1 += *(const LAS f32x4*)(lds + ((((w * 2 + 1) * 8 + i) * 64 + lp) * 16)); }
            const int row = 16 * i + (lp & 15), cq = 4 * (lp >> 4);
            if constexpr (PAIR) f.pair4(MP + row, (j >> 3) * 128 + (j & 7) * 16 + cq, v0, v1);
            else { pg8::Unit u{0, 0, ksl}; f.apply4(u, MP + row, c0 + cq, v0); f.apply4(u, MP + row, c1 + cq, v1); }
        }
    }
    __syncthreads();
}


#define MFMA32(a, b, c) __builtin_amdgcn_mfma_f32_32x32x16_bf16((a), (b), (c), 0, 0, 0)
constexpr int TS = 272;
DI int pi32(int r) { return (r & ~12) | ((r & 4) << 1) | ((r & 8) >> 1); }
DI int keyloc(int i, int hh) { return 16 * (i >> 3) + 8 * hh + (i & 7); }
DI bf16x8 frag_tr(LAS const unsigned char* img, int st, int k0, int m0, int lane) {
    const int hh = lane >> 5, blk = (lane >> 4) & 1, i16 = lane & 15, q = i16 >> 2, p = i16 & 3;
    LAS const unsigned char* a = img + (k0 + 8 * hh + q) * st + (m0 + 16 * blk) * 2 + 8 * p;
    const s16x4 lo = __builtin_amdgcn_ds_read_tr16_b64_v4i16((LAS s16x4*)a), hi = __builtin_amdgcn_ds_read_tr16_b64_v4i16((LAS s16x4*)(a + 4 * st));
    return __builtin_shufflevector(lo, hi, 0, 1, 2, 3, 4, 5, 6, 7);
}
DI bf16x8 frag_row(LAS const unsigned char* img, int st, int row, int k0, int hh) { return *(const LAS bf16x8*)(img + row * st + (k0 + 8 * hh) * 2); }
DI bf16x8 pack8(const f32x16& x, int s) {
    u32x4 p; p[0] = pk2(x[8 * s + 0], x[8 * s + 1]); p[1] = pk2(x[8 * s + 2], x[8 * s + 3]); p[2] = pk2(x[8 * s + 4], x[8 * s + 5]); p[3] = pk2(x[8 * s + 6], x[8 * s + 7]);
    return __builtin_bit_cast(bf16x8, p);
}
DI f32x16 zero16() { f32x16 z;
#pragma unroll
    for (int i = 0; i < 16; ++i) z[i] = 0.f; return z; }
DI void block_scan(LAS float* a, int n, LAS float* tmp, int tid) {
    const int lane = tid & 63, wid = tid >> 6;
    f32x4 v = (f32x4){0.f, 0.f, 0.f, 0.f};
    if (tid * 4 < n) v = *(LAS f32x4*)(a + tid * 4);
    v[1] += v[0]; v[2] += v[1]; v[3] += v[2];
    float s = v[3];
#pragma unroll
    for (int o = 1; o < 64; o <<= 1) { const float t = __shfl_up(s, o); if (lane >= o) s += t; }
    if (lane == 63) tmp[wid] = s;
    __syncthreads();
    float off = s - v[3];
    for (int w = 0; w < wid; ++w) off += tmp[w];
    if (tid * 4 < n) *(LAS f32x4*)(a + tid * 4) = v + off;
    __syncthreads();
}

template <bool SB>
DI void attn_prompt_unit(LAS unsigned char* lds, const bf16* q, const bf16* k, const bf16* v, bf16* out, int b, int hcol, int ocol, int qb, LAS const float* negc, const int wv_) {
    const int tid = wv_ * 64 + lane_id_();
    const int lane = tid & 63, wid = __builtin_amdgcn_readfirstlane(tid >> 6), r = lane & 31, hh = lane >> 5;
    LAS unsigned char* Kt = lds + 16384;
    LAS unsigned char* Vt = Kt + 2 * 64 * TS;
    const int q0 = 256 * qb + 32 * wid;
    const size_t rowb = (size_t)b * SEQ;
    bf16x8 Qf[8];
#pragma unroll
    for (int ks = 0; ks < 8; ++ks) Qf[ks] = *(const bf16x8*)(q + (rowb + q0 + r) * DM + hcol + 16 * ks + 8 * hh);
    f32x16 O[4];
#pragma unroll
    for (int d = 0; d < 4; ++d) O[d] = zero16();
    float m = -INFINITY, l = 0.f, carry = 0.f;
    const int ktmax = 4 * qb + 3, ntile = ktmax + 1;
    const int lrow = tid >> 3, lch = (tid & 7) * 2;
    u32x4 kr[2], vr[2];
    auto gload = [&](int kt) {
        const size_t base = (rowb + 64 * kt + lrow) * DM + hcol + lch * 8;
        kr[0] = *(const u32x4*)(k + base); kr[1] = *(const u32x4*)(k + base + 8); vr[0] = *(const u32x4*)(v + base); vr[1] = *(const u32x4*)(v + base + 8); };
    auto lstore = [&](int buf) {
        LAS unsigned char* kp = Kt + buf * 64 * TS + lrow * TS + lch * 16; LAS unsigned char* vp = Vt + buf * 64 * TS + lrow * TS + lch * 16;
        *(LAS u32x4*)kp = kr[0]; *(LAS u32x4*)(kp + 16) = kr[1]; *(LAS u32x4*)vp = vr[0]; *(LAS u32x4*)(vp + 16) = vr[1]; };
    auto tile_of = [&](int it) { return SB ? (ktmax - it) : it; };
    __syncthreads();
    gload(tile_of(0)); lstore(0);
    __syncthreads();
    for (int it = 0; it < ntile; ++it) {
        const int kt = tile_of(it), buf = it & 1;
        if (it + 1 < ntile) gload(tile_of(it + 1));
        const int key0 = 64 * kt;
        const bool relevant = SB ? (key0 < q0 + 31) : (key0 <= q0 + 31);
        if (relevant) {
            const bool full = SB ? (key0 + 63 < q0) : (key0 + 63 <= q0);
            LAS const unsigned char* Kb = Kt + buf * 64 * TS; LAS const unsigned char* Vb = Vt + buf * 64 * TS;
            f32x16 S[2];
#pragma unroll
            for (int blk = 0; blk < 2; ++blk) {
                if (!SB) {
#pragma unroll
                    for (int g = 0; g < 2; ++g) { const f32x4 c0 = *(const LAS f32x4*)(negc + key0 + 32 * blk + 16 * g + 8 * hh), c1 = *(const LAS f32x4*)(negc + key0 + 32 * blk + 16 * g + 8 * hh + 4);
                        S[blk][8 * g + 0] = c0[0]; S[blk][8 * g + 1] = c0[1]; S[blk][8 * g + 2] = c0[2]; S[blk][8 * g + 3] = c0[3]; S[blk][8 * g + 4] = c1[0]; S[blk][8 * g + 5] = c1[1]; S[blk][8 * g + 6] = c1[2]; S[blk][8 * g + 7] = c1[3]; }
                } else S[blk] = zero16();
#pragma unroll
                for (int ks = 0; ks < 8; ++ks) S[blk] = MFMA32(frag_row(Kb, TS, 32 * blk + pi32(r), 16 * ks, hh), Qf[ks], S[blk]);
            }
            const int qq = q0 + r;
            if (!SB) {
                if (!full) {
#pragma unroll
                    for (int blk = 0; blk < 2; ++blk)
#pragma unroll
                        for (int i = 0; i < 16; ++i) if (key0 + 32 * blk + keyloc(i, hh) > qq) S[blk][i] = -INFINITY;
                }
                float mx = S[0][0];
#pragma unroll
                for (int blk = 0; blk < 2; ++blk)
#pragma unroll
                    for (int i = 0; i < 16; ++i) mx = fmaxf(mx, S[blk][i]);
                mx = fmaxf(mx, __shfl_xor(mx, 32));
                const float mn = fmaxf(m, mx), corr = fexp2(m - mn);
                float ps = 0.f;
#pragma unroll
                for (int blk = 0; blk < 2; ++blk)
#pragma unroll
                    for (int i = 0; i < 16; ++i) { S[blk][i] = fexp2(S[blk][i] - mn); ps += S[blk][i]; }
                l = l * corr + ps; m = mn;
#pragma unroll
                for (int d = 0; d < 4; ++d) O[d] = O[d] * corr;
            } else {
                f32x16 L[2]; float G[4], Go[4];
#pragma unroll
                for (int blk = 0; blk < 2; ++blk)
#pragma unroll
                    for (int g = 0; g < 2; ++g) { float gs = 0.f;
#pragma unroll
                        for (int j = 0; j < 8; ++j) { const int i = 8 * g + j; const float z = S[blk][i];
                            const bool ok = full || (key0 + 32 * blk + keyloc(i, hh) < qq);
                            const float lsm = ok ? -(fmaxf(z, 0.f) + flog2(1.0f + fexp2(-fabsf(z)))) : 0.f;
                            L[blk][i] = lsm; S[blk][i] = ok ? z : -INFINITY; gs += lsm; }
                        G[2 * blk + g] = gs; }
#pragma unroll
                for (int u = 0; u < 4; ++u) Go[u] = __shfl_xor(G[u], 32);
                float above = carry;
#pragma unroll
                for (int u = 3; u >= 0; --u) {
                    float run = above + (hh == 0 ? Go[u] : 0.f);
                    const int blk = u >> 1, g = u & 1;
#pragma unroll
                    for (int j = 7; j >= 0; --j) { const int i = 8 * g + j; run += L[blk][i]; S[blk][i] = fexp2(S[blk][i] + run); }
                    above += G[u] + Go[u];
                }
                carry = above;
            }
#pragma unroll
            for (int ks = 0; ks < 4; ++ks) { const bf16x8 pf = pack8(S[ks >> 1], ks & 1);
#pragma unroll
                for (int d = 0; d < 4; ++d) O[d] = MFMA32(frag_tr(Vb, TS, 16 * ks, 32 * d, lane), pf, O[d]); }
        }
        if (it + 1 < ntile) lstore((it + 1) & 1);
        __syncthreads();
    }
    float inv = 1.0f;
    if (!SB) { const float lt = l + __shfl_xor(l, 32); inv = 1.0f / lt; }
    bf16* op = out + (rowb + q0 + r) * DM + ocol;
#pragma unroll
    for (int d = 0; d < 4; ++d)
#pragma unroll
        for (int g = 0; g < 4; ++g) { u32x2 w; w.x = pk2(O[d][4 * g + 0] * inv, O[d][4 * g + 1] * inv); w.y = pk2(O[d][4 * g + 2] * inv, O[d][4 * g + 3] * inv);
            *(u32x2*)(op + 32 * d + 8 * g + 4 * hh) = w; }
}


DI void hgrn_scan16(const float* lfb, size_t row0, int hc, LAS float* tot, int tid, float (&lf)[16], float (&bl)[16], float& blast, float& bref) {
    const int ch = tid & 127, tq = tid >> 7;
    float run = 0.f;
#pragma unroll
    for (int j = 0; j < 16; ++j) { lf[j] = lfb[(row0 + 16 * tq + j) * W_B + hc + ch]; run += lf[j]; bl[j] = run; }
    __syncthreads();
    tot[tq * 128 + ch] = run;
    __syncthreads();
    const float t0 = tot[ch], t1 = tot[128 + ch], t2 = tot[256 + ch], t3 = tot[384 + ch];
    const float base = (tq > 0 ? t0 : 0.f) + (tq > 1 ? t1 : 0.f) + (tq > 2 ? t2 : 0.f);
#pragma unroll
    for (int j = 0; j < 16; ++j) bl[j] += base;
    blast = (t0 + t1) + (t2 + t3); bref = t0 + t1;
}
DI void copy_tile_bf16(LAS unsigned char* dst, const bf16* src, size_t ld, int rows, int tid) {
    for (int c = tid; c < rows * 16; c += NTHREADS) { const int rr = c >> 4, ch = c & 15; *(LAS u32x4*)(dst + rr * TS + ch * 16) = *(const u32x4*)(src + (size_t)rr * ld + ch * 8); }
}
DI void hgrn_local_unit(LAS unsigned char* lds, const float* lfb, const bf16* ibb, float* dS, float* Dc, int unit, const int wv_) {
    const int tid = wv_ * 64 + lane_id_();
    const int lane = tid & 63, wid = __builtin_amdgcn_readfirstlane(tid >> 6), r = lane & 31, hh = lane >> 5;
    const int bh = unit >> 5, c = unit & 31, b = bh >> 3, h = bh & 7, hc = h * 128;
    const size_t row0 = (size_t)b * SEQ + 64 * c;
    LAS unsigned char* KI = lds; LAS unsigned char* IB = lds + 64 * TS; LAS float* tot = (LAS float*)(lds + 2 * 64 * TS);
    float lf[16], bl[16], blast, bref;
    hgrn_scan16(lfb, row0, hc, tot, tid, lf, bl, blast, bref);
    { const int ch = tid & 127, tq = tid >> 7;
#pragma unroll
      for (int j = 0; j < 16; ++j) { const float kk = (1.0f - __expf(lf[j])) * __expf(blast - bl[j]); *(LAS unsigned short*)(KI + (16 * tq + j) * TS + ch * 2) = (unsigned short)f2bf(kk); }
      if (tq == 0) Dc[(size_t)unit * 128 + ch] = __expf(blast); }
    copy_tile_bf16(IB, ibb + row0 * W_B + hc, W_B, 64, tid);
    __syncthreads();
    const int vblk = wid >> 1, cb0 = (wid & 1) * 2;
    f32x16 acc[2] = {zero16(), zero16()};
#pragma unroll
    for (int ks = 0; ks < 4; ++ks) { const bf16x8 af = frag_tr(IB, TS, 16 * ks, 32 * vblk, lane);
#pragma unroll
        for (int cb = 0; cb < 2; ++cb) acc[cb] = MFMA32(af, frag_tr(KI, TS, 16 * ks, 32 * (cb0 + cb), lane), acc[cb]); }
#pragma unroll
    for (int cb = 0; cb < 2; ++cb)
#pragma unroll
        for (int i = 0; i < 16; ++i) { const int v = 32 * vblk + (i & 3) + 8 * (i >> 2) + 4 * hh; dS[((size_t)unit * 128 + v) * 128 + 32 * (cb0 + cb) + r] = acc[cb][i]; }
    __syncthreads();
}
DI void hgrn_scan_phase(const float* dS, const float* Dc, bf16* Sc, float* hs_out, int G, int tid) {
    for (int gid = blockIdx.x * NTHREADS + tid; gid < 32 * 128 * 32; gid += G * NTHREADS) {
        const int bh = gid >> 12, v = (gid >> 5) & 127, c4 = (gid & 31) * 4;
        f32x4 S = (f32x4){0.f, 0.f, 0.f, 0.f};
#pragma unroll 4
        for (int ck = 0; ck < 32; ++ck) { const size_t unit = (size_t)bh * 32 + ck, idx = (unit * 128 + v) * 128 + c4;
            u32x2 w; w.x = pk2(S[0], S[1]); w.y = pk2(S[2], S[3]); *(u32x2*)(Sc + idx) = w;
            const f32x4 d = *(const f32x4*)(Dc + unit * 128 + c4), x = *(const f32x4*)(dS + idx); S = d * S + x; }
#pragma unroll
        for (int e = 0; e < 4; ++e) hs_out[((size_t)bh * 128 + c4 + e) * 128 + v] = S[e];
    }
}
DI void hgrn_out_unit(LAS unsigned char* lds, const float* lfb, const bf16* qbb, const bf16* ibb, const bf16* gbb, const bf16* Sc, bf16* mrg, int unit, const int wv_) {
    const int tid = wv_ * 64 + lane_id_();
    const int lane = tid & 63, wid = __builtin_amdgcn_readfirstlane(tid >> 6), r = lane & 31, hh = lane >> 5;
    const int bh = unit >> 5, c = unit & 31, b = bh >> 3, h = bh & 7, hc = h * 128;
    const size_t row0 = (size_t)b * SEQ + 64 * c;
    LAS unsigned char* QF = lds; LAS unsigned char* QM = lds + 64 * TS; LAS unsigned char* KM = lds + 2 * 64 * TS; LAS unsigned char* IB = lds + 3 * 64 * TS; LAS unsigned char* ST = lds + 4 * 64 * TS;
    LAS float* tot = (LAS float*)(lds + 4 * 64 * TS + 128 * TS); LAS float* red = tot + 512;
    float lf[16], bl[16], blast, bref;
    hgrn_scan16(lfb, row0, hc, tot, tid, lf, bl, blast, bref);
    { const int ch = tid & 127, tq = tid >> 7;
#pragma unroll
      for (int j = 0; j < 16; ++j) { const int t = 16 * tq + j; const float qv = bf2f(qbb[(row0 + t) * W_B + hc + ch]);
          *(LAS unsigned short*)(QF + t * TS + ch * 2) = (unsigned short)f2bf(qv * __expf(bl[j]));
          *(LAS unsigned short*)(QM + t * TS + ch * 2) = (unsigned short)f2bf(qv * __expf(bl[j] - bref));
          *(LAS unsigned short*)(KM + t * TS + ch * 2) = (unsigned short)f2bf((1.0f - __expf(lf[j])) * __expf(bref - bl[j])); } }
    copy_tile_bf16(IB, ibb + row0 * W_B + hc, W_B, 64, tid);
    copy_tile_bf16(ST, Sc + (size_t)unit * 128 * 128, 128, 128, tid);
    __syncthreads();
    const int vblk = wid & 3, tblk = wid >> 2;
    f32x16 SA[2] = {zero16(), zero16()};
#pragma unroll
    for (int sb = 0; sb < 2; ++sb)
#pragma unroll
        for (int ks = 0; ks < 8; ++ks) SA[sb] = MFMA32(frag_row(KM, TS, 32 * sb + pi32(r), 16 * ks, hh), frag_row(QM, TS, 32 * tblk + r, 16 * ks, hh), SA[sb]);
    const int tt = 32 * tblk + r;
#pragma unroll
    for (int sb = 0; sb < 2; ++sb)
#pragma unroll
        for (int i = 0; i < 16; ++i) if (32 * sb + keyloc(i, hh) > tt) SA[sb][i] = 0.f;
    f32x16 O = zero16();
#pragma unroll
    for (int ks = 0; ks < 4; ++ks) O = MFMA32(frag_tr(IB, TS, 16 * ks, 32 * vblk, lane), pack8(SA[ks >> 1], ks & 1), O);
#pragma unroll
    for (int ks = 0; ks < 8; ++ks) O = MFMA32(frag_row(ST, TS, 32 * vblk + r, 16 * ks, hh), frag_row(QF, TS, 32 * tblk + r, 16 * ks, hh), O);
    float ss = 0.f;
#pragma unroll
    for (int i = 0; i < 16; ++i) ss += O[i] * O[i];
    ss += __shfl_xor(ss, 32);
    if (hh == 0) red[vblk * 64 + tt] = ss;
    __syncthreads();
    const float rstd = 1.0f / sqrtf(((red[tt] + red[64 + tt]) + (red[128 + tt] + red[192 + tt])) * (1.0f / 128.0f) + RMS_EPS);
#pragma unroll
    for (int g = 0; g < 4; ++g) { const int v = 32 * vblk + 8 * g + 4 * hh;
        const u32x2 gw = *(const u32x2*)(gbb + (row0 + tt) * W_B + hc + v);
        const float g0 = bf2f((unsigned short)(gw.x & 0xffff)), g1 = bf2f((unsigned short)(gw.x >> 16)), g2 = bf2f((unsigned short)(gw.y & 0xffff)), g3 = bf2f((unsigned short)(gw.y >> 16));
        u32x2 w; w.x = pk2(O[4 * g + 0] * rstd * g0, O[4 * g + 1] * rstd * g1); w.y = pk2(O[4 * g + 2] * rstd * g2, O[4 * g + 3] * rstd * g3);
        *(u32x2*)(mrg + (row0 + tt) * DM + W_A + hc + v) = w; }
    __syncthreads();
}
DI void hgrn_sample_unit(LAS unsigned char* lds, const float* lfb, const bf16* qbb, const bf16* ibb, const bf16* gbb, const float* s0, float* hs_out, bf16* mrg, int unit, const int wv_) {
    const int tid = wv_ * 64 + lane_id_();
    const int b = unit >> 3, h = unit & 7, hc = h * 128;
    const size_t row0 = (size_t)MP + b * 16;
    LAS float* fl = (LAS float*)lds; LAS float* ql = fl + 2048; LAS float* il = ql + 2048; LAS float* part = il + 2048;
    __syncthreads();
    for (int e = tid; e < 2048; e += NTHREADS) { const int t = e >> 7, c = e & 127; const size_t g = (row0 + t) * W_B + hc + c;
        fl[e] = __expf(lfb[g]); ql[e] = bf2f(qbb[g]); il[e] = bf2f(ibb[g]); }
    __syncthreads();
    const int v = tid & 127, cq = tid >> 7;
    float S[32];
#pragma unroll
    for (int j = 0; j < 32; ++j) S[j] = s0[((size_t)unit * 128 + 32 * cq + j) * 128 + v];
#pragma unroll 1
    for (int t = 0; t < 16; ++t) { const float iv = il[t * 128 + v]; float o = 0.f;
#pragma unroll
        for (int j = 0; j < 32; ++j) { const float f = fl[t * 128 + 32 * cq + j]; S[j] = f * S[j] + (1.0f - f) * iv; o += S[j] * ql[t * 128 + 32 * cq + j]; }
        part[(cq * 16 + t) * 128 + v] = o; }
#pragma unroll
    for (int j = 0; j < 32; ++j) hs_out[((size_t)unit * 128 + 32 * cq + j) * 128 + v] = S[j];
    __syncthreads();
    { const int t = tid >> 5, v4 = (tid & 31) * 4; f32x4 o = (f32x4){0.f, 0.f, 0.f, 0.f};
#pragma unroll
      for (int q4 = 0; q4 < 4; ++q4) o += *(const LAS f32x4*)(part + (q4 * 16 + t) * 128 + v4);
      float ss = (o[0] * o[0] + o[1] * o[1]) + (o[2] * o[2] + o[3] * o[3]);
#pragma unroll
      for (int of = 1; of < 32; of <<= 1) ss += __shfl_xor(ss, of);
      const float rstd = 1.0f / sqrtf(ss * (1.0f / 128.0f) + RMS_EPS);
      const size_t g = (row0 + t) * W_B + hc + v4;
      u32x2 w; w.x = pk2(o[0] * rstd * bf2f(gbb[g]), o[1] * rstd * bf2f(gbb[g + 1])); w.y = pk2(o[2] * rstd * bf2f(gbb[g + 2]), o[3] * rstd * bf2f(gbb[g + 3]));
      *(u32x2*)(mrg + (row0 + t) * DM + W_A + hc + v4) = w; }
    __syncthreads();
}


template <bool SB>
DI void attn_sample_unit(LAS unsigned char* lds, const bf16* q, const float* ck, const float* cv, const float* nk, const float* nv, const float* clf, const float* nlf,
                         bf16* out, int b, int h, int H, const int wv_) {
    const int tid = wv_ * 64 + lane_id_();
    const int lane = tid & 63, wid = __builtin_amdgcn_readfirstlane(tid >> 6), r = lane & 31, hh = lane >> 5, t = r & 15;
    const int hcol = h * 128; const size_t stride = (size_t)H * 128;
    LAS float* negc = (LAS float*)lds; LAS float* tmp = negc + 1056; LAS float* Ow = (LAS float*)(lds + 8192); LAS float* mlw = (LAS float*)(lds + 8192 + 65536);
    __syncthreads();
    if (!SB) {
        for (int e = tid; e < 1056; e += NTHREADS) negc[e] = e < 1024 ? clf[((size_t)b * 1024 + e) * H + h] : (e < 1040 ? nlf[((size_t)b * 16 + e - 1024) * H + h] : 0.f);
        __syncthreads();
        block_scan(negc, 1056, tmp, tid);
        for (int e = tid; e < 1056; e += NTHREADS) negc[e] = -negc[e] * LOG2E;
        __syncthreads();
    }
    const size_t qrow = (size_t)MP + b * 16 + t;
    bf16x8 Qf[8];
#pragma unroll
    for (int ks = 0; ks < 8; ++ks) Qf[ks] = *(const bf16x8*)(q + qrow * DM + hcol + 16 * ks + 8 * hh);
    const int blo = (wid * 33) >> 3, bhi = ((wid + 1) * 33) >> 3;
    auto kbase = [&](const float* c, const float* n, int blk) { return blk < 32 ? c + (((size_t)b * 1024 + 32 * blk) * H + h) * 128 : n + (((size_t)b * 16) * H + h) * 128; };
    auto scores = [&](int blk, f32x16& S) {
        const float* kb_ = kbase(ck, nk, blk); const int kmax = blk < 32 ? 31 : 15;
        const int kl = pi32(r); const float* kp = kb_ + (size_t)(kl < kmax ? kl : kmax) * stride + 8 * hh;
#pragma unroll
        for (int ks = 0; ks < 8; ++ks) { const f32x4 a = *(const f32x4*)(kp + 16 * ks), c = *(const f32x4*)(kp + 16 * ks + 4);
            u32x4 p; p[0] = pk2(a[0], a[1]); p[1] = pk2(a[2], a[3]); p[2] = pk2(c[0], c[1]); p[3] = pk2(c[2], c[3]);
            S = MFMA32(__builtin_bit_cast(bf16x8, p), Qf[ks], S); } };
    auto pv = [&](int blk, const f32x16& P, f32x16 (&O)[4]) {
        const float* vb_ = kbase(cv, nv, blk); const int kmax = blk < 32 ? 31 : 15;
#pragma unroll
        for (int s = 0; s < 2; ++s) { const bf16x8 pf = pack8(P, s);
#pragma unroll
            for (int d = 0; d < 4; ++d) { float x[8];
#pragma unroll
                for (int j = 0; j < 8; ++j) { const int kl = 16 * s + 8 * hh + j; x[j] = vb_[(size_t)(kl < kmax ? kl : kmax) * stride + 32 * d + r]; }
                u32x4 p; p[0] = pk2(x[0], x[1]); p[1] = pk2(x[2], x[3]); p[2] = pk2(x[4], x[5]); p[3] = pk2(x[6], x[7]);
                O[d] = MFMA32(__builtin_bit_cast(bf16x8, p), pf, O[d]); } } };
    f32x16 O[4] = {zero16(), zero16(), zero16(), zero16()};
    if (!SB) {
        float m = -INFINITY, l = 0.f;
        for (int blk = blo; blk < bhi; ++blk) {
            f32x16 S;
#pragma unroll
            for (int g = 0; g < 2; ++g) { const f32x4 c0 = *(const LAS f32x4*)(negc + 32 * blk + 16 * g + 8 * hh), c1 = *(const LAS f32x4*)(negc + 32 * blk + 16 * g + 8 * hh + 4);
                S[8 * g + 0] = c0[0]; S[8 * g + 1] = c0[1]; S[8 * g + 2] = c0[2]; S[8 * g + 3] = c0[3]; S[8 * g + 4] = c1[0]; S[8 * g + 5] = c1[1]; S[8 * g + 6] = c1[2]; S[8 * g + 7] = c1[3]; }
            scores(blk, S);
            float mx = -INFINITY;
#pragma unroll
            for (int i = 0; i < 16; ++i) { const int key = 32 * blk + keyloc(i, hh); if (key > 1024 + t) S[i] = -INFINITY; mx = fmaxf(mx, S[i]); }
            mx = fmaxf(mx, __shfl_xor(mx, 32));
            const float mn = fmaxf(m, mx), corr = fexp2(m - mn); float ps = 0.f;
#pragma unroll
            for (int i = 0; i < 16; ++i) { S[i] = fexp2(S[i] - mn); ps += S[i]; }
            l = l * corr + ps; m = mn;
#pragma unroll
            for (int d = 0; d < 4; ++d) O[d] = O[d] * corr;
            pv(blk, S, O);
        }
        l += __shfl_xor(l, 32);
        if (lane < 16) { mlw[wid * 16 + lane] = m; mlw[128 + wid * 16 + lane] = l; }
    } else {
        float tot = 0.f;
        for (int blk = blo; blk < bhi; ++blk) { f32x16 S = zero16(); scores(blk, S);
#pragma unroll
            for (int i = 0; i < 16; ++i) { const int key = 32 * blk + keyloc(i, hh); const float z = S[i]; if (key < 1024 + t) tot += -(fmaxf(z, 0.f) + flog2(1.0f + fexp2(-fabsf(z)))); } }
        tot += __shfl_xor(tot, 32);
        if (lane < 16) mlw[256 + wid * 16 + lane] = tot;
        __syncthreads();
        float carry = 0.f;
        for (int w = wid + 1; w < 8; ++w) carry += mlw[256 + w * 16 + t];
        for (int blk = bhi - 1; blk >= blo; --blk) { f32x16 S = zero16(), L; scores(blk, S);
            float G[2], Go[2];
#pragma unroll
            for (int g = 0; g < 2; ++g) { float gs = 0.f;
#pragma unroll
                for (int j = 0; j < 8; ++j) { const int i = 8 * g + j; const float z = S[i]; const bool ok = (32 * blk + keyloc(i, hh)) < 1024 + t;
                    const float lsm = ok ? -(fmaxf(z, 0.f) + flog2(1.0f + fexp2(-fabsf(z)))) : 0.f; L[i] = lsm; S[i] = ok ? z : -INFINITY; gs += lsm; }
                G[g] = gs; }
            Go[0] = __shfl_xor(G[0], 32); Go[1] = __shfl_xor(G[1], 32);
            float above = carry;
#pragma unroll
            for (int u = 1; u >= 0; --u) { float run = above + (hh == 0 ? Go[u] : 0.f);
#pragma unroll
                for (int j = 7; j >= 0; --j) { const int i = 8 * u + j; run += L[i]; S[i] = fexp2(S[i] + run); }
                above += G[u] + Go[u]; }
            carry = above;
            pv(blk, S, O);
        }
    }
    if (r < 16) {
#pragma unroll
        for (int d = 0; d < 4; ++d)
#pragma unroll
            for (int i = 0; i < 16; ++i) Ow[(wid * 128 + 32 * d + (i & 3) + 8 * (i >> 2) + 4 * hh) * 16 + r] = O[d][i];
    }
    __syncthreads();
    { const int tq = tid >> 5, d4 = (tid & 31) * 4; float sc[8]; float Lt = 1.0f;
      if (!SB) { float M = -INFINITY;
#pragma unroll
          for (int w = 0; w < 8; ++w) M = fmaxf(M, mlw[w * 16 + tq]);
          Lt = 0.f;
#pragma unroll
          for (int w = 0; w < 8; ++w) { sc[w] = fexp2(mlw[w * 16 + tq] - M); Lt += mlw[128 + w * 16 + tq] * sc[w]; }
          Lt = 1.0f / Lt; }
      else {
#pragma unroll
          for (int w = 0; w < 8; ++w) sc[w] = 1.0f; }
      float o[4] = {0.f, 0.f, 0.f, 0.f};
#pragma unroll
      for (int w = 0; w < 8; ++w)
#pragma unroll
          for (int e = 0; e < 4; ++e) o[e] += Ow[(w * 128 + d4 + e) * 16 + tq] * sc[w];
      u32x2 wv; wv.x = pk2(o[0] * Lt, o[1] * Lt); wv.y = pk2(o[2] * Lt, o[3] * Lt);
      *(u32x2*)(out + ((size_t)MP + b * 16 + tq) * DM + hcol + d4) = wv; }
    __syncthreads();
}

struct FMemKV { float* ok; float* ov; bf16* kb;
    DI void apply4(const pg8::Unit&, int row, int col, f32x4 v) const {
        if (col < DM) { *(f32x4*)(ok + (size_t)row * DM + col) = v; u32x2 w; w.x = pk2(v[0], v[1]); w.y = pk2(v[2], v[3]); *(u32x2*)(kb + (size_t)row * DM + col) = w; }
        else { *(f32x4*)(ov + (size_t)row * DM + (col - DM)) = v; }
    } };
struct FBf16 { bf16* o; int ld; float sc;
    DI void apply4(const pg8::Unit&, int row, int col, f32x4 v) const { u32x2 w; w.x = pk2(v[0] * sc, v[1] * sc); w.y = pk2(v[2] * sc, v[3] * sc); *(u32x2*)(o + (size_t)row * ld + col) = w; } };


struct FSwiglu { bf16* h;
    DI void pair4(int row, int hc, f32x4 g, f32x4 u) const { u32x2 w; w.x = pk2(siluf_(g[0]) * u[0], siluf_(g[1]) * u[1]); w.y = pk2(siluf_(g[2]) * u[2], siluf_(g[3]) * u[3]);
        *(u32x2*)(h + (size_t)row * D_FF + hc) = w; } };
struct FResid { float* x32; float sc;
    DI void apply4(const pg8::Unit&, int row, int col, f32x4 v) const { float* p = x32 + (size_t)row * DM + col; const f32x4 r = *(const f32x4*)p; *(f32x4*)p = r * ALPHA + v * sc; } };
constexpr float QS128 = 0.08838834764831845f * LOG2E;
constexpr float QS512 = 0.04419417382415922f * LOG2E;
struct FEvenIn { float* out; unsigned char* ws; const float *b_f, *lbl, *ng;
    DI void apply4(const pg8::Unit&, int row, int col, f32x4 v) const {
        const int seg = col >> 10, c = col & 1023; const bool smp = row >= MP;
        if (seg == 0) { u32x2 w; w.x = pk2(v[0] * QS128, v[1] * QS128); w.y = pk2(v[2] * QS128, v[3] * QS128); *(u32x2*)((bf16*)(ws + WS_Q) + (size_t)row * DM + c) = w; }
        else if (seg == 1 || seg == 2) {
            const size_t oo = smp ? (seg == 1 ? O_FKS : O_FVS) + (size_t)(row - MP) * W_A + c : (seg == 1 ? O_FK : O_FV) + (size_t)row * W_A + c;
            *(f32x4*)(out + oo) = v;
            if (!smp) { u32x2 w; w.x = pk2(v[0], v[1]); w.y = pk2(v[2], v[3]); *(u32x2*)((bf16*)(ws + (seg == 1 ? WS_KB : WS_VB)) + (size_t)row * DM + c) = w; }
        } else if (seg == 3) { u32x2 w; w.x = pk2(siluf_(v[0]), siluf_(v[1])); w.y = pk2(siluf_(v[2]), siluf_(v[3])); *(u32x2*)((bf16*)(ws + WS_QBB) + (size_t)row * W_B + c) = w; }
        else if (seg == 4) { const f32x4 l0 = *(const f32x4*)(lbl + c), l1 = *(const f32x4*)(lbl + W_B + c); f32x4 r;
#pragma unroll
            for (int e = 0; e < 4; ++e) { const float lb = 1.0f / (1.0f + __expf(l1[e] - l0[e])); r[e] = __logf(lb + (1.0f - lb) * sigmoidf_(v[e])); }
            *(f32x4*)((float*)(ws + WS_LFB) + (size_t)row * W_B + c) = r; }
        else if (seg == 5) { u32x2 w; w.x = pk2(v[0], v[1]); w.y = pk2(v[2], v[3]); *(u32x2*)((bf16*)(ws + WS_IBB) + (size_t)row * W_B + c) = w; }
        else if (seg == 6) { const f32x4 g = *(const f32x4*)(ng + c); u32x2 w; w.x = pk2(g[0] * siluf_(v[0]), g[1] * siluf_(v[1])); w.y = pk2(g[2] * siluf_(v[2]), g[3] * siluf_(v[3])); *(u32x2*)((bf16*)(ws + WS_GBB) + (size_t)row * W_B + c) = w; }
        else if (c < 8) { const f32x4 b = *(const f32x4*)(b_f + c); f32x4 r;
#pragma unroll
            for (int e = 0; e < 4; ++e) r[e] = logsigmoidf_(v[e] + b[e]);
            const size_t oo = smp ? O_FLFS + (size_t)(row - MP) * H_A + c : O_FLF + (size_t)row * H_A + c;
            *(f32x4*)(out + oo) = r; }
    } };
struct FOddIn { float* out; unsigned char* ws;
    DI void apply4(const pg8::Unit&, int row, int col, f32x4 v) const {
        const int seg = col >> 11, c = col & 2047; const bool smp = row >= MP;
        if (seg == 0) { u32x2 w; w.x = pk2(v[0] * QS128, v[1] * QS128); w.y = pk2(v[2] * QS128, v[3] * QS128); *(u32x2*)((bf16*)(ws + WS_Q) + (size_t)row * DM + c) = w; }
        else { const size_t oo = smp ? (seg == 1 ? O_SKS : O_SVS) + (size_t)(row - MP) * W_C + c : (seg == 1 ? O_SK : O_SV) + (size_t)row * W_C + c;
            *(f32x4*)(out + oo) = v;
            if (!smp) { u32x2 w; w.x = pk2(v[0], v[1]); w.y = pk2(v[2], v[3]); *(u32x2*)((bf16*)(ws + (seg == 1 ? WS_KB : WS_VB)) + (size_t)row * DM + c) = w; } }
    } };
struct CrossSOrder { const bf16* Q; const bf16* Kmem; int lda, ldb, G, c;
    DI bool next(int i, pg8::Unit& u) const { const int L = i * G + c; if (L >= 128) return false; u.z = L >> 3; u.pm = L & 7; u.pn = 0; return true; }
    DI const char* pa(const pg8::Unit& u) const { return (const char*)(Q + ((size_t)(u.z >> 2) * SEQ + 256 * u.pm) * DM + (u.z & 3) * HD_X); }
    DI const char* pb(const pg8::Unit& u) const { return (const char*)(Kmem + ((size_t)(u.z >> 2) * N_MEM) * DM + (u.z & 3) * HD_X); } };
struct CrossOOrder { const bf16* P; const bf16* VT; int lda, ldb, G, c;
    DI bool next(int i, pg8::Unit& u) const { const int L = i * G + c; if (L >= 256) return false; u.z = L >> 4; u.pm = (L >> 1) & 7; u.pn = L & 1; return true; }
    DI const char* pa(const pg8::Unit& u) const { return (const char*)(P + ((size_t)(u.z >> 2) * SEQ + 256 * u.pm) * 1024 + (u.z & 3) * N_MEM); }
    DI const char* pb(const pg8::Unit& u) const { return (const char*)(VT + ((size_t)(u.z & 3) * HD_X + 256 * u.pn) * 1024 + (u.z >> 2) * N_MEM); } };
struct FCrossO { bf16* o;
    DI void apply4(const pg8::Unit& u, int row, int col, f32x4 v) const { u32x2 w; w.x = pk2(v[0], v[1]); w.y = pk2(v[2], v[3]);
        *(u32x2*)(o + ((size_t)(u.z >> 2) * SEQ + row) * DM + (u.z & 3) * HD_X + col) = w; } };
struct EpiSoftmax {
    static constexpr bool AFTER_DRAIN = true;
    bf16* P;
    DI void fused(f32x4 (&acc)[2][2][4][2], const pg8::Unit& u, int wr, int wc, int fr, int fq, LAS unsigned char* lds, int wid, int lane) const {
        LAS float* MX = (LAS float*)lds; LAS float* SM = MX + 1024;
        float rm[2][4];
#pragma unroll
        for (int ai = 0; ai < 2; ++ai)
#pragma unroll
            for (int m = 0; m < 4; ++m) { float mx = -INFINITY;
#pragma unroll
                for (int bj = 0; bj < 2; ++bj)
#pragma unroll
                    for (int n = 0; n < 2; ++n) { const f32x4 x = acc[ai][bj][m][n]; mx = fmaxf(mx, fmaxf(fmaxf(x[0], x[1]), fmaxf(x[2], x[3]))); }
                mx = fmaxf(mx, __shfl_xor(mx, 16)); mx = fmaxf(mx, __shfl_xor(mx, 32));
                if (fq == 0) MX[(ai * 128 + wr * 64 + m * 16 + fr) * 4 + wc] = mx; }
        __syncthreads();
#pragma unroll
        for (int ai = 0; ai < 2; ++ai)
#pragma unroll
            for (int m = 0; m < 4; ++m) { const f32x4 q4 = *(const LAS f32x4*)(MX + (ai * 128 + wr * 64 + m * 16 + fr) * 4); const float M = fmaxf(fmaxf(q4[0], q4[1]), fmaxf(q4[2], q4[3])); float s = 0.f;
#pragma unroll
                for (int bj = 0; bj < 2; ++bj)
#pragma unroll
                    for (int n = 0; n < 2; ++n) { f32x4 x = acc[ai][bj][m][n]; x[0] = fexp2(x[0] - M); x[1] = fexp2(x[1] - M); x[2] = fexp2(x[2] - M); x[3] = fexp2(x[3] - M); acc[ai][bj][m][n] = x; s += (x[0] + x[1]) + (x[2] + x[3]); }
                s += __shfl_xor(s, 16); s += __shfl_xor(s, 32);
                if (fq == 0) SM[(ai * 128 + wr * 64 + m * 16 + fr) * 4 + wc] = s; rm[ai][m] = 0.f; }
        __syncthreads();
#pragma unroll
        for (int ai = 0; ai < 2; ++ai)
#pragma unroll
            for (int m = 0; m < 4; ++m) { const int rl = ai * 128 + wr * 64 + m * 16 + fr; const f32x4 q4 = *(const LAS f32x4*)(SM + rl * 4); const float inv = 1.0f / ((q4[0] + q4[1]) + (q4[2] + q4[3]));
                bf16* pr = P + ((size_t)(u.z >> 2) * SEQ + 256 * u.pm + rl) * 1024 + (u.z & 3) * N_MEM;
#pragma unroll
                for (int bj = 0; bj < 2; ++bj)
#pragma unroll
                    for (int n = 0; n < 2; ++n) { const f32x4 x = acc[ai][bj][m][n] * inv; u32x2 w; w.x = pk2(x[0], x[1]); w.y = pk2(x[2], x[3]); *(u32x2*)(pr + bj * 128 + wc * 32 + n * 16 + 4 * fq) = w; } }
        (void)rm; (void)wid; (void)lane;
    }
};
DI void cross_sample_unit(LAS unsigned char* lds, const bf16* q, const float* mk, const float* mv, bf16* out, int b, int hx, const int wv_) {
    const int tid = wv_ * 64 + lane_id_();
    const int lane = tid & 63, wid = __builtin_amdgcn_readfirstlane(tid >> 6), r = lane & 31, hh = lane >> 5, t = r & 15;
    LAS float* Ow = (LAS float*)(lds + 8192); LAS float* mlw = (LAS float*)lds;
    const float* kp = mk + ((size_t)b * N_MEM + 32 * wid + pi32(r)) * DM + hx * HD_X + 8 * hh;
    const bf16* qp = q + ((size_t)MP + b * 16 + t) * DM + hx * HD_X + 8 * hh;
    __syncthreads();
    f32x16 S = zero16();
#pragma unroll 8
    for (int ks = 0; ks < 32; ++ks) { const f32x4 a = *(const f32x4*)(kp + 16 * ks), c = *(const f32x4*)(kp + 16 * ks + 4);
        u32x4 p; p[0] = pk2(a[0], a[1]); p[1] = pk2(a[2], a[3]); p[2] = pk2(c[0], c[1]); p[3] = pk2(c[2], c[3]);
        S = MFMA32(__builtin_bit_cast(bf16x8, p), *(const bf16x8*)(qp + 16 * ks), S); }
    float mx = S[0];
#pragma unroll
    for (int i = 1; i < 16; ++i) mx = fmaxf(mx, S[i]);
    mx = fmaxf(mx, __shfl_xor(mx, 32));
    if (lane < 16) mlw[wid * 16 + lane] = mx;
    __syncthreads();
    float M = -INFINITY;
#pragma unroll
    for (int w = 0; w < 8; ++w) M = fmaxf(M, mlw[w * 16 + t]);
    float ps = 0.f;
#pragma unroll
    for (int i = 0; i < 16; ++i) { S[i] = fexp2(S[i] - M); ps += S[i]; }
    ps += __shfl_xor(ps, 32);
    if (lane < 16) mlw[128 + wid * 16 + lane] = ps;
    const bf16x8 pf0 = pack8(S, 0), pf1 = pack8(S, 1);
    const float* vp = mv + ((size_t)b * N_MEM + 32 * wid) * DM + hx * HD_X + r;
#pragma unroll 1
    for (int pass = 0; pass < 4; ++pass) {
        f32x16 O[4] = {zero16(), zero16(), zero16(), zero16()};
#pragma unroll
        for (int s = 0; s < 2; ++s)
#pragma unroll
            for (int d = 0; d < 4; ++d) { float x[8];
#pragma unroll
                for (int j = 0; j < 8; ++j) x[j] = vp[(size_t)(16 * s + 8 * hh + j) * DM + 128 * pass + 32 * d];
                u32x4 p; p[0] = pk2(x[0], x[1]); p[1] = pk2(x[2], x[3]); p[2] = pk2(x[4], x[5]); p[3] = pk2(x[6], x[7]);
                O[d] = MFMA32(__builtin_bit_cast(bf16x8, p), s == 0 ? pf0 : pf1, O[d]); }
        __syncthreads();
        if (r < 16) {
#pragma unroll
            for (int d = 0; d < 4; ++d)
#pragma unroll
                for (int i = 0; i < 16; ++i) Ow[(wid * 128 + 32 * d + (i & 3) + 8 * (i >> 2) + 4 * hh) * 16 + r] = O[d][i]; }
        __syncthreads();
        { const int tq = tid >> 5, d4 = (tid & 31) * 4; float Lt = 0.f;
#pragma unroll
          for (int w = 0; w < 8; ++w) Lt += mlw[128 + w * 16 + tq];
          Lt = 1.0f / Lt; float o[4] = {0.f, 0.f, 0.f, 0.f};
#pragma unroll
          for (int w = 0; w < 8; ++w)
#pragma unroll
              for (int e = 0; e < 4; ++e) o[e] += Ow[(w * 128 + d4 + e) * 16 + tq];
          u32x2 wv; wv.x = pk2(o[0] * Lt, o[1] * Lt); wv.y = pk2(o[2] * Lt, o[3] * Lt);
          *(u32x2*)(out + ((size_t)MP + b * 16 + tq) * DM + hx * HD_X + 128 * pass + d4) = wv; }
    }
    __syncthreads();
}

struct FPart { float* part;
    DI void apply4(const pg8::Unit& u, int row, int col, f32x4 v) const { *(f32x4*)(part + ((size_t)u.z * MS + (row - MP)) * DM + col) = v; } };
DI void ln_phase(float* x32, bf16* xb, const float* g, const float* b, float* yout, const float* part, float psc, int gw, int NGW, int lane) {
    for (int row = gw; row < MT; row += NGW) {
        float* xr = x32 + (size_t)row * DM;
        f32x4 v[8]; float s = 0.f;
#pragma unroll
        for (int j = 0; j < 8; ++j) v[j] = *(const f32x4*)(xr + (lane + 64 * j) * 4);
        if (row >= MP) {
#pragma unroll
            for (int j = 0; j < 8; ++j) { const float* pp = part + (size_t)(row - MP) * DM + (lane + 64 * j) * 4;
                const f32x4 ps = (*(const f32x4*)pp + *(const f32x4*)(pp + (size_t)MS * DM)) + (*(const f32x4*)(pp + (size_t)2 * MS * DM) + *(const f32x4*)(pp + (size_t)3 * MS * DM));
                v[j] = v[j] * ALPHA + ps * psc; } }
#pragma unroll
        for (int j = 0; j < 8; ++j) s += (v[j][0] + v[j][1]) + (v[j][2] + v[j][3]);
        const float mean = wave_sum(s) * (1.0f / DM); float s2 = 0.f;
#pragma unroll
        for (int j = 0; j < 8; ++j) { v[j] = v[j] - mean; s2 += (v[j][0] * v[j][0] + v[j][1] * v[j][1]) + (v[j][2] * v[j][2] + v[j][3] * v[j][3]); }
        const float rstd = 1.0f / sqrtf(wave_sum(s2) * (1.0f / DM) + LN_EPS);
#pragma unroll
        for (int j = 0; j < 8; ++j) { const int cc = (lane + 64 * j) * 4; const f32x4 gg = *(const f32x4*)(g + cc), bb = *(const f32x4*)(b + cc);
            const f32x4 y = v[j] * rstd * gg + bb; *(f32x4*)(xr + cc) = y;
            u32x2 w; w.x = pk2(y[0], y[1]); w.y = pk2(y[2], y[3]); *(u32x2*)(xb + (size_t)row * DM + cc) = w;
            if (yout) *(f32x4*)(yout + (size_t)row * DM + cc) = y; }
    }
}

struct Args { const float* in[29]; float* out; unsigned char* ws; int ph_lo, ph_hi; };

template <int MODE>
DI int wmap(int n) {
    if (MODE == 1) return (n >> 7) * 256 + (n & 127);
    if (MODE == 2) return (n >> 7) * 256 + 128 + (n & 127);
    if (MODE == 3) return n < 3072 ? n : (n < 3080 ? 7168 + (n - 3072) : n - 8);
    return n;
}
template <int MODE>
DI void transpose_item(const float* W, int K, int N, bf16* WT, LAS float* scr, int item, int lane) {
    const int nblk = (N + 63) / 64, kb = item / nblk, nb = item % nblk, k0 = 64 * kb, n0 = 64 * nb;
    const int n4 = (lane & 15) * 4, kr = lane >> 4;
    f32x4 v[16];
#pragma unroll
    for (int i = 0; i < 16; ++i) v[i] = (n0 + n4 < N) ? *(const f32x4*)(W + (size_t)(k0 + 4 * i + kr) * N + n0 + n4) : (f32x4){0.f, 0.f, 0.f, 0.f};
#pragma unroll
    for (int i = 0; i < 16; ++i) { LAS float* d = scr + (4 * i + kr) * 65 + n4; d[0] = v[i][0]; d[1] = v[i][1]; d[2] = v[i][2]; d[3] = v[i][3]; }
    LDS_WAIT(); asm volatile("" ::: "memory");
    const int c = lane & 7;
#pragma unroll
    for (int j = 0; j < 8; ++j) { const int n = (lane >> 3) + 8 * j; const LAS float* s = scr + (8 * c) * 65 + n;
        u32x4 o; o.x = pk2(s[0 * 65], s[1 * 65]); o.y = pk2(s[2 * 65], s[3 * 65]); o.z = pk2(s[4 * 65], s[5 * 65]); o.w = pk2(s[6 * 65], s[7 * 65]);
        if (n0 + n < N) *(u32x4*)(WT + (size_t)wmap<MODE>(n0 + n) * K + k0 + 8 * c) = o; }
    LDS_WAIT(); asm volatile("" ::: "memory");
}

DI bool in_phase_(int lo, int hi, int k) { asm volatile("" : "+s"(lo), "+s"(hi)); return lo <= k && k < hi; }
#define IN(k) in_phase_(lo, hi, (k))
#ifdef PROBE_TIMING
#define SEAM(k) do { if (IN(k) && IN((k) + 1)) xcd_barrier(bar); if (blockIdx.x == 0 && bar.wv == 0 && lane_id_() == 0) ((volatile LAS unsigned*)(lds + MISC_OFF))[64 + (k) + 1] = (unsigned)__builtin_amdgcn_s_memrealtime(); } while (0)
#else
#define SEAM(k) do { if (IN(k) && IN((k) + 1)) xcd_barrier(bar); } while (0)
#endif
#define PH_BEGIN const int lane = lane_id_(); const int tid = wave * 64 + lane; (void)tid; GAS unsigned char* ws_g = (GAS unsigned char*)args.ws; asm volatile("" : "+s"(ws_g)); unsigned char* ws = (unsigned char*)ws_g; GAS float* out_g = (GAS float*)args.out; asm volatile("" : "+s"(out_g)); float* outp = (float*)out_g; \
    bf16* Wgu = (bf16*)(ws + WS_WGU); bf16* Wd = (bf16*)(ws + WS_WD); bf16* Wq = (bf16*)(ws + WS_WQ); bf16* Wkv = (bf16*)(ws + WS_WKV); bf16* Wo = (bf16*)(ws + WS_WO); \
    bf16* WinE = (bf16*)(ws + WS_WINE); bf16* WoutE = (bf16*)(ws + WS_WOUTE); bf16* WinO = (bf16*)(ws + WS_WINO); bf16* WoutO = (bf16*)(ws + WS_WOUTO); \
    float* x32 = (float*)(ws + WS_X32); bf16* xb = (bf16*)(ws + WS_XB); \
    bf16* memb = (bf16*)(ws + WS_MEMB); bf16* memK = (bf16*)(ws + WS_MEMK); bf16* memVT = (bf16*)(ws + WS_MEMVT); \
    bf16* hbuf = (bf16*)(ws + WS_H); bf16* mrg = (bf16*)(ws + WS_MRG); bf16* qbuf = (bf16*)(ws + WS_Q); bf16* kbuf = (bf16*)(ws + WS_KB); bf16* vbuf = (bf16*)(ws + WS_VB); \
    bf16* qbb = (bf16*)(ws + WS_QBB); bf16* ibb = (bf16*)(ws + WS_IBB); bf16* gbb = (bf16*)(ws + WS_GBB); float* lfb = (float*)(ws + WS_LFB); \
    (void)Wgu; (void)Wd; (void)Wq; (void)Wkv; (void)Wo; (void)WinE; (void)WoutE; (void)WinO; (void)WoutO; (void)x32; (void)xb; (void)memb; (void)memK; (void)memVT; \
    (void)hbuf; (void)mrg; (void)qbuf; (void)kbuf; (void)vbuf; (void)qbb; (void)ibb; (void)gbb; (void)lfb; (void)outp;
#define INP(k) ({ GAS const float* _p = (GAS const float*)args.in[k]; asm volatile("" : "+s"(_p)); (const float*)_p; })

template <int l>
DI void layer_body(const Args& args, LAS unsigned char* lds, const int wave, const int G, const int lo, const int hi, const XcdBarrier& bar) {
    const int gw = blockIdx.x * NWAVES + wave, NGW = G * NWAVES;
    const int pb = 1 + l * PH_PER_LAYER;
        if (IN(pb + 0)) {
            PH_BEGIN
            const bf16* W = Wgu + (size_t)(2 * l) * NGU * DM;
            { pg8::GridOrder S; S.init(xb, DM, W, DM, 33, 43, G, (int)blockIdx.x); pg8::EpiPair<FSwiglu, true> E{{hbuf}}; pg8::gemm_phase(lds, S, DM, E, wave); }
            const bool g256 = (G == 256); const int cu = (int)blockIdx.x;
            { pg8::GridOrder S; S.init(memb, DM, Wkv + (size_t)l * 2 * DM * DM, DM, 4, 16, G, g256 ? cu - 139 : cu);
              pg8::EpiEach<FMemKV> E{{outp + O_MK + (size_t)l * 1024 * DM, outp + O_MV + (size_t)l * 1024 * DM, memK + (size_t)l * 1024 * DM}};
              pg8::gemm_phase(lds, S, DM, E, wave); }
            { pg8::GridOrder S; S.init(Wkv + (size_t)l * 2 * DM * DM + (size_t)DM * DM, DM, memb, DM, 8, 4, G, g256 ? cu - 203 : cu);
              pg8::EpiEach<FBf16> E{{memVT + (size_t)l * DM * 1024, 1024, 1.0f}};
              pg8::gemm_phase(lds, S, DM, E, wave); }
        }
        SEAM(pb + 0);
        if (IN(pb + 1)) {
            PH_BEGIN
            const bf16* W = Wd + (size_t)(2 * l) * DM * D_FF;
            { pg8::GridOrder S; S.init(hbuf, D_FF, W, D_FF, 32, 8, G, (int)blockIdx.x); pg8::EpiEach<FResid> E{{x32, 0.5f}}; pg8::gemm_phase(lds, S, D_FF, E, wave); }
            skinny_phase<false, 4>(lds, hbuf + (size_t)MP * D_FF, D_FF, W, D_FF, D_FF, 256, FPart{(float*)(ws + WS_PART)}, wave, 0, G);
        }
        SEAM(pb + 1);
        if (IN(pb + 2)) { PH_BEGIN ln_phase(x32, xb, INP(11) + (size_t)(l * 4 + 0) * DM, INP(12) + (size_t)(l * 4 + 0) * DM, nullptr, (const float*)(ws + WS_PART), 0.5f, gw, NGW, lane); }
        SEAM(pb + 2);
        if (IN(pb + 3)) {
            PH_BEGIN
            if constexpr (l == 0) {
                const FEvenIn f{outp, ws, INP(23), INP(24), INP(25)};
                { pg8::GridOrder S; S.init(xb, DM, WinE, DM, 33, 29, G, (int)blockIdx.x); pg8::EpiEach<FEvenIn, true> E{f}; pg8::gemm_phase(lds, S, DM, E, wave); }
            } else {
                const FOddIn f{outp, ws};
                { pg8::GridOrder S; S.init(xb, DM, WinO, DM, 32, 24, G, (int)blockIdx.x); pg8::EpiEach<FOddIn> E{f}; pg8::gemm_phase(lds, S, DM, E, wave); }
                skinny_phase<false, 1>(lds, xb + (size_t)MP * DM, DM, WinO, DM, DM, 192, f, wave, 0, G);
            }
        }
        SEAM(pb + 3);
        if (IN(pb + 4)) {
            PH_BEGIN
            const int cu = (int)blockIdx.x, rc = G - 1 - cu;
            if constexpr (l == 0) {
                LAS float* negc = (LAS float*)lds; LAS float* stmp = (LAS float*)(lds + 8192);
#pragma unroll 1
                for (int u = cu; u < 256; u += G) {
                    const int qb = 7 - (u >> 5), bh = u & 31, b = bh >> 3, h = bh & 7;
                    __syncthreads();
                    for (int e = tid; e < 512; e += NTHREADS) { f32x4 a;
#pragma unroll
                        for (int k4 = 0; k4 < 4; ++k4) a[k4] = outp[O_FLF + ((size_t)b * SEQ + 4 * e + k4) * H_A + h];
                        *(LAS f32x4*)(negc + 4 * e) = a; }
                    __syncthreads();
                    block_scan(negc, 2048, stmp, tid);
                    for (int e = tid; e < 2048; e += NTHREADS) negc[e] = -negc[e] * LOG2E;
                    __syncthreads();
                    attn_prompt_unit<false>(lds, qbuf, kbuf, vbuf, mrg, b, h * 128, h * 128, qb, negc, wave);
                }
                __syncthreads();
#pragma unroll 1
                for (int u = cu; u < 1024; u += G) hgrn_local_unit(lds, lfb, ibb, (float*)(ws + WS_DS), (float*)(ws + WS_DC), u, wave);
#pragma unroll 1
                for (int u = rc; u < 64; u += G) attn_sample_unit<false>(lds, qbuf, INP(3), INP(4), outp + O_FKS, outp + O_FVS, INP(5), outp + O_FLFS, mrg, u >> 3, u & 7, H_A, wave);
#pragma unroll 1
                for (int u = rc - 64; u >= 0 && u < 64; u += G) hgrn_sample_unit(lds, lfb, qbb, ibb, gbb, INP(6), outp + O_HSS, mrg, u, wave);
            } else {
#pragma unroll 1
                for (int u = cu; u < 512; u += G) {
                    const int uu = u & 255, bh = uu & 63, qb = u < 256 ? 7 - (uu >> 6) : (uu >> 6);
                    attn_prompt_unit<true>(lds, qbuf, kbuf, vbuf, mrg, bh >> 4, (bh & 15) * 128, (bh & 15) * 128, qb, nullptr, wave);
                }
#pragma unroll 1
                for (int u = rc; u < 128; u += G) attn_sample_unit<true>(lds, qbuf, INP(7), INP(8), outp + O_SKS, outp + O_SVS, nullptr, nullptr, mrg, u >> 4, u & 15, H_C, wave);
            }
        }
        SEAM(pb + 4);
        if (IN(pb + 5)) { PH_BEGIN if constexpr (l == 0) hgrn_scan_phase((const float*)(ws + WS_DS), (const float*)(ws + WS_DC), (bf16*)(ws + WS_SC), outp + O_HS, G, tid); }
        SEAM(pb + 5);
        if (IN(pb + 6)) { PH_BEGIN if constexpr (l == 0) {
#pragma unroll 1
            for (int u = (int)blockIdx.x; u < 1024; u += G) hgrn_out_unit(lds, lfb, qbb, ibb, gbb, (const bf16*)(ws + WS_SC), mrg, u, wave); } }
        SEAM(pb + 6);
        if (IN(pb + 7)) {
            PH_BEGIN
            const bf16* W = l == 0 ? WoutE : WoutO;
            { pg8::GridOrder S; S.init(mrg, DM, W, DM, 32, 8, G, (int)blockIdx.x); pg8::EpiEach<FResid> E{{x32, 1.0f}}; pg8::gemm_phase(lds, S, DM, E, wave); }
            skinny_phase<false, 4>(lds, mrg + (size_t)MP * DM, DM, W, DM, DM, 256, FPart{(float*)(ws + WS_PART)}, wave, 0, G);
        }
        SEAM(pb + 7);
        if (IN(pb + 8)) { PH_BEGIN ln_phase(x32, xb, INP(11) + (size_t)(l * 4 + 1) * DM, INP(12) + (size_t)(l * 4 + 1) * DM, nullptr, (const float*)(ws + WS_PART), 1.0f, gw, NGW, lane); }
        SEAM(pb + 8);
        if (IN(pb + 9)) {
            PH_BEGIN
            const bf16* W = Wq + (size_t)l * DM * DM;
            { pg8::GridOrder S; S.init(xb, DM, W, DM, 32, 8, G, (int)blockIdx.x); pg8::EpiEach<FBf16> E{{qbuf, DM, QS512}}; pg8::gemm_phase(lds, S, DM, E, wave); }
            skinny_phase<false, 1>(lds, xb + (size_t)MP * DM, DM, W, DM, DM, 64, FBf16{qbuf, DM, QS512}, wave, 0, G);
        }
        SEAM(pb + 9);
        if (IN(pb + 10)) {
            PH_BEGIN
            { CrossSOrder S{qbuf, memK + (size_t)l * 1024 * DM, DM, DM, G, (int)blockIdx.x}; EpiSoftmax E{(bf16*)(ws + WS_P)}; pg8::gemm_phase(lds, S, HD_X, E, wave); }
#pragma unroll 1
            for (int u = G - 1 - (int)blockIdx.x; u < 32; u += G)
                cross_sample_unit(lds, qbuf, INP(9) + (size_t)l * DEC_B * N_MEM * DM, INP(10) + (size_t)l * DEC_B * N_MEM * DM, mrg, u >> 2, u & 3, wave);
        }
        SEAM(pb + 10);
        if (IN(pb + 11)) {
            PH_BEGIN
            CrossOOrder S{(const bf16*)(ws + WS_P), memVT + (size_t)l * DM * 1024, 1024, 1024, G, (int)blockIdx.x}; pg8::EpiEach<FCrossO> E{{mrg}}; pg8::gemm_phase(lds, S, N_MEM, E, wave);
        }
        SEAM(pb + 11);
        if (IN(pb + 12)) {
            PH_BEGIN
            const bf16* W = Wo + (size_t)l * DM * DM;
            { pg8::GridOrder S; S.init(mrg, DM, W, DM, 32, 8, G, (int)blockIdx.x); pg8::EpiEach<FResid> E{{x32, 1.0f}}; pg8::gemm_phase(lds, S, DM, E, wave); }
            skinny_phase<false, 4>(lds, mrg + (size_t)MP * DM, DM, W, DM, DM, 256, FPart{(float*)(ws + WS_PART)}, wave, 0, G);
        }
        SEAM(pb + 12);
        if (IN(pb + 13)) { PH_BEGIN ln_phase(x32, xb, INP(11) + (size_t)(l * 4 + 2) * DM, INP(12) + (size_t)(l * 4 + 2) * DM, nullptr, (const float*)(ws + WS_PART), 1.0f, gw, NGW, lane); }
        SEAM(pb + 13);
        if (IN(pb + 14)) {
            PH_BEGIN
            const bf16* W = Wgu + (size_t)(2 * l + 1) * NGU * DM;
            { pg8::GridOrder S; S.init(xb, DM, W, DM, 33, 43, G, (int)blockIdx.x); pg8::EpiPair<FSwiglu, true> E{{hbuf}}; pg8::gemm_phase(lds, S, DM, E, wave); }
        }
        SEAM(pb + 14);
        if (IN(pb + 15)) {
            PH_BEGIN
            const bf16* W = Wd + (size_t)(2 * l + 1) * DM * D_FF;
            { pg8::GridOrder S; S.init(hbuf, D_FF, W, D_FF, 32, 8, G, (int)blockIdx.x); pg8::EpiEach<FResid> E{{x32, 0.5f}}; pg8::gemm_phase(lds, S, D_FF, E, wave); }
            skinny_phase<false, 4>(lds, hbuf + (size_t)MP * D_FF, D_FF, W, D_FF, D_FF, 256, FPart{(float*)(ws + WS_PART)}, wave, 0, G);
        }
        SEAM(pb + 15);
        if (IN(pb + 16)) { PH_BEGIN ln_phase(x32, xb, INP(11) + (size_t)(l * 4 + 3) * DM, INP(12) + (size_t)(l * 4 + 3) * DM, l == 1 ? outp + O_Y : nullptr, (const float*)(ws + WS_PART), 0.5f, gw, NGW, lane); }
        SEAM(pb + 16);
    }
__global__ void __launch_bounds__(NTHREADS, 2) fwd(Args args) {
    extern __shared__ __attribute__((aligned(16))) unsigned char lds_raw[];
    LAS unsigned char* lds = (LAS unsigned char*)lds_raw;
    const int tid0 = threadIdx.x, wave = __builtin_amdgcn_readfirstlane(tid0 >> 6);
    const int G = gridDim.x;
    unsigned* ctl = (unsigned*)(args.ws + WS_CTL);
    volatile LAS unsigned* MISC = (volatile LAS unsigned*)(lds + MISC_OFF);
    for (int u = tid0; u < (LDS_BYTES - MISC_OFF) / 4; u += NTHREADS) ((LAS unsigned*)(lds + MISC_OFF))[u] = 0u;
    __syncthreads();
    const int lo = args.ph_lo, hi = args.ph_hi;
    const bool multi = (hi - lo) > 1;
    XcdBarrier bar; bar.bar = ctl + CW_BAR; bar.x = 0; bar.st = nullptr;
    if (multi) bar = xcd_barrier_post(ctl + CW_BAR, MISC + 8);
    bar.wv = wave;
#ifdef PROBE_TIMING
    if (blockIdx.x == 0 && wave == 0 && lane_id_() == 0) ((volatile LAS unsigned*)(lds + MISC_OFF))[64] = (unsigned)__builtin_amdgcn_s_memrealtime();
#endif

    const int gw = blockIdx.x * NWAVES + wave, NGW = G * NWAVES;
    if (IN(0)) {
        PH_BEGIN
        LAS float* scr = (LAS float*)(lds + wave * 16640);
        constexpr int I_GU = 32 * 86, I_D = 86 * 32, I_22 = 32 * 32, I_KV = 32 * 64, I_INE = 32 * 113, I_INO = 32 * 96;
        constexpr int PER_L = 6 * I_GU + 2 * I_22 + I_KV;
        constexpr int NITEMS = 2 * PER_L + I_INE + I_22 + I_INO + I_22;
        static_assert(I_GU == I_D, "items");
#pragma unroll 1
        for (int it = gw; it < NITEMS; it += NGW) {
            int r = it;
            if (r < 2 * PER_L) {
                const int l = r / PER_L; r -= l * PER_L;
                if (r < I_GU) { transpose_item<1>(INP(13) + (size_t)l * DM * D_FF, DM, D_FF, Wgu + (size_t)(2 * l) * NGU * DM, scr, r, lane); continue; } r -= I_GU;
                if (r < I_GU) { transpose_item<2>(INP(14) + (size_t)l * DM * D_FF, DM, D_FF, Wgu + (size_t)(2 * l) * NGU * DM, scr, r, lane); continue; } r -= I_GU;
                if (r < I_D) { transpose_item<0>(INP(15) + (size_t)l * DM * D_FF, D_FF, DM, Wd + (size_t)(2 * l) * DM * D_FF, scr, r, lane); continue; } r -= I_D;
                if (r < I_GU) { transpose_item<1>(INP(16) + (size_t)l * DM * D_FF, DM, D_FF, Wgu + (size_t)(2 * l + 1) * NGU * DM, scr, r, lane); continue; } r -= I_GU;
                if (r < I_GU) { transpose_item<2>(INP(17) + (size_t)l * DM * D_FF, DM, D_FF, Wgu + (size_t)(2 * l + 1) * NGU * DM, scr, r, lane); continue; } r -= I_GU;
                if (r < I_D) { transpose_item<0>(INP(18) + (size_t)l * DM * D_FF, D_FF, DM, Wd + (size_t)(2 * l + 1) * DM * D_FF, scr, r, lane); continue; } r -= I_D;
                if (r < I_22) { transpose_item<0>(INP(19) + (size_t)l * DM * DM, DM, DM, Wq + (size_t)l * DM * DM, scr, r, lane); continue; } r -= I_22;
                if (r < I_KV) { transpose_item<0>(INP(20) + (size_t)l * DM * 2 * DM, DM, 2 * DM, Wkv + (size_t)l * 2 * DM * DM, scr, r, lane); continue; } r -= I_KV;
                transpose_item<0>(INP(21) + (size_t)l * DM * DM, DM, DM, Wo + (size_t)l * DM * DM, scr, r, lane); continue;
            }
            r -= 2 * PER_L;
            if (r < I_INE) { transpose_item<3>(INP(22), DM, D_IN_EVEN, WinE, scr, r, lane); continue; } r -= I_INE;
            if (r < I_22) { transpose_item<0>(INP(26), DM, DM, WoutE, scr, r, lane); continue; } r -= I_22;
            if (r < I_INO) { transpose_item<0>(INP(27), DM, D_IN_ODD, WinO, scr, r, lane); continue; } r -= I_INO;
            transpose_item<0>(INP(28), DM, DM, WoutO, scr, r, lane);
        }
        for (int i = gw * 64 + lane; i < (NE - D_IN_EVEN) * DM / 8; i += NGW * 64) *(u32x4*)(WinE + (size_t)D_IN_EVEN * DM + (size_t)i * 8) = (u32x4){0u, 0u, 0u, 0u};
#pragma unroll 1
        for (int m = gw; m < MT + 1024; m += NGW) {
            const float* src; float* d32 = nullptr; bf16* d16;
            if (m < MP) { src = INP(0) + (size_t)m * DM; d32 = x32 + (size_t)m * DM; d16 = xb + (size_t)m * DM; }
            else if (m < MT) { src = INP(1) + (size_t)(m - MP) * DM; d32 = x32 + (size_t)m * DM; d16 = xb + (size_t)m * DM; }
            else { src = INP(2) + (size_t)(m - MT) * DM; d16 = memb + (size_t)(m - MT) * DM; }
#pragma unroll
            for (int j = 0; j < 8; ++j) { const f32x4 v = *(const f32x4*)(src + (lane + 64 * j) * 4); if (d32) *(f32x4*)(d32 + (lane + 64 * j) * 4) = v;
                u32x2 w; w.x = pk2(v[0], v[1]); w.y = pk2(v[2], v[3]); *(u32x2*)(d16 + (lane + 64 * j) * 4) = w; }
        }
    }
    SEAM(0);
    layer_body<0>(args, lds, wave, G, lo, hi, bar);
    layer_body<1>(args, lds, wave, G, lo, hi, bar);
#ifdef PROBE_TIMING
    xcd_barrier(bar);
    if (blockIdx.x == 0 && wave == 0) {
        volatile LAS unsigned* T = (volatile LAS unsigned*)(lds + MISC_OFF) + 64;
        const int ln = lane_id_();
        auto dur = [&](int k) { return (int)(T[k + 1] - T[k]); };
        int cat[10];
#pragma unroll
        for (int c = 0; c < 10; ++c) cat[c] = 0;
        cat[0] = dur(0);
#pragma unroll
        for (int l = 0; l < 2; ++l) { const int pb = 1 + 17 * l;
            cat[1] += dur(pb + 0) + dur(pb + 14); cat[2] += dur(pb + 1) + dur(pb + 15); cat[3] += dur(pb + 2) + dur(pb + 8) + dur(pb + 13) + dur(pb + 16); cat[4] += dur(pb + 3);
            if (l == 0) { cat[5] += dur(pb + 4); cat[6] += dur(pb + 5) + dur(pb + 6); } else { cat[7] += dur(pb + 4); }
            cat[8] += dur(pb + 7) + dur(pb + 9) + dur(pb + 12); cat[9] += dur(pb + 10) + dur(pb + 11); }
        const size_t offs[5] = {O_Y, O_FK, O_FV, O_SK, O_SV};
#pragma unroll
        for (int c = 0; c < 5; ++c) { const int n = cat[c + PROBE_SET * 5] / 800; for (int i = ln; i < n; i += 64) ((unsigned*)args.out)[offs[c] + i] = 0xAAAAAAAAu; }
    }
#endif
#undef IN
#undef SEAM
}

constexpr int N_PHASES = 1 + 2 * PH_PER_LAYER;

extern "C" void kernel_launch(void* const* d_in, const int* in_sizes, int n_in, void* d_out, int out_size, void* d_ws, size_t ws_size, hipStream_t stream) {
    static int grid = 0;
    if (grid == 0) {
        if (n_in != 29 || (size_t)out_size != O_END || ws_size < WS_END) { fprintf(stderr, "kernel_launch: unexpected sizes n_in %d out %d ws %zu (need %zu)\n", n_in, out_size, ws_size, (size_t)WS_END); grid = -1; return; }
        int dev = 0, cus = 0, per_cu = 0;
        if (hipGetDevice(&dev) != hipSuccess || hipDeviceGetAttribute(&cus, hipDeviceAttributeMultiprocessorCount, dev) != hipSuccess) { grid = -1; return; }
        if (hipFuncSetAttribute((const void*)fwd, hipFuncAttributeMaxDynamicSharedMemorySize, LDS_BYTES) != hipSuccess) { fprintf(stderr, "kernel_launch: hipFuncSetAttribute failed\n"); grid = -1; return; }
        if (hipOccupancyMaxActiveBlocksPerMultiprocessor(&per_cu, (const void*)fwd, NTHREADS, LDS_BYTES) != hipSuccess || per_cu < 1) fprintf(stderr, "kernel_launch: occupancy query says %d\n", per_cu);
        (void)hipGetLastError();
        grid = cus;
    }
    if (grid < 0) return;
    (void)hipMemsetAsync((char*)d_ws + WS_CTL, 0, CTL_ZERO_BYTES, stream);
    Args a{};
    for (int i = 0; i < 29; ++i) a.in[i] = (const float*)d_in[i];
    a.out = (float*)d_out; a.ws = (unsigned char*)d_ws;
#ifdef MULTI_LAUNCH
    for (int p = 0; p < N_PHASES; ++p) { a.ph_lo = p; a.ph_hi = p + 1; hipLaunchKernelGGL(fwd, dim3(grid), dim3(NTHREADS), LDS_BYTES, stream, a); }
#else
    a.ph_lo = 0; a.ph_hi = N_PHASES; hipLaunchKernelGGL(fwd, dim3(grid), dim3(NTHREADS), LDS_BYTES, stream, a);
#endif
}
```
